# Optimizing an MI355X kernel written in HIP

```python
import math
import jax, jax.numpy as jnp
from jax import lax
import numpy as np

D_MODEL = 1024
BATCH = 8
SEQ = 4096
DEPTH = 1

HEAD_DIM = 64
SB_HEADS = 8
SB_WIDTH = SB_HEADS * HEAD_DIM
DIFF_HEADS = 4
DIFF_QK_DIM = 64
DIFF_V_DIM = 2 * DIFF_QK_DIM
DIFF_QK_WIDTH = DIFF_HEADS * 2 * DIFF_QK_DIM
DIFF_V_WIDTH = DIFF_HEADS * DIFF_V_DIM
N_BRANCHES = 2
IN_SPLITS = (SB_WIDTH, SB_WIDTH, SB_WIDTH, DIFF_QK_WIDTH, DIFF_QK_WIDTH, DIFF_V_WIDTH, D_MODEL, D_MODEL)
IN_WIDTH = 3 * SB_WIDTH + 2 * DIFF_QK_WIDTH + DIFF_V_WIDTH + N_BRANCHES * D_MODEL
Q_BLOCK = 128
ROPE_THETA = 10000.0
N_GROUPS = 4
EXPERTS_PER_GROUP = 8
N_EXPERTS = N_GROUPS * EXPERTS_PER_GROUP
TOP_K = 2
D_EXPERT = 256
EXPERT_BLOCK = 128
EPS = 1e-6

kernel_name = "hybrid_stickbreak_diffattn_hiermoe"


def rmsnorm(x, g):
    xf = x.astype(jnp.float32)
    y = xf * lax.rsqrt(jnp.mean(xf * xf, axis=-1, keepdims=True) + EPS)
    return (y * g.astype(jnp.float32)).astype(x.dtype)


def rope_tables(seq_len, dim):
    pos = jnp.arange(seq_len, dtype=jnp.float32)
    inv_freq = 1.0 / (ROPE_THETA ** (jnp.arange(0, dim, 2, dtype=jnp.float32) / dim))
    freqs = pos[:, None] * inv_freq[None, :]
    emb = jnp.concatenate([freqs, freqs], axis=-1)
    return jnp.cos(emb), jnp.sin(emb)


def apply_rope(x, cos, sin):
    xf = x.astype(jnp.float32)
    half = xf.shape[-1] // 2
    rot = jnp.concatenate([-xf[..., half:], xf[..., :half]], axis=-1)
    return (xf * cos + rot * sin).astype(x.dtype)


def split_heads(t, n_heads, d):
    b, s, _ = t.shape
    return t.reshape(b, s, n_heads, d).transpose(0, 2, 1, 3)


def merge_heads(t):
    b, h, s, d = t.shape
    return t.transpose(0, 2, 1, 3).reshape(b, s, h * d)


def stick_breaking_attention(q, k, v):
    seq_len = q.shape[2]
    scale = HEAD_DIM ** -0.5
    outs = []
    for blk in range(seq_len // Q_BLOCK):
        q0 = blk * Q_BLOCK
        kv_len = q0 + Q_BLOCK
        qb = q[:, :, q0:kv_len]
        kb = k[:, :, :kv_len]
        vb = v[:, :, :kv_len]
        z = jnp.einsum('bhqd,bhkd->bhqk', qb, kb, preferred_element_type=jnp.float32) * scale
        qpos = q0 + jnp.arange(Q_BLOCK)[:, None]
        kpos = jnp.arange(kv_len)[None, :]
        strict = kpos < qpos
        log_1m_beta = jnp.where(strict, jax.nn.log_sigmoid(-z), 0.0)
        after = lax.cumsum(log_1m_beta, axis=3, reverse=True) - log_1m_beta
        a = jnp.where(strict, jnp.exp(jax.nn.log_sigmoid(z) + after), 0.0)
        outs.append(jnp.einsum('bhqk,bhkd->bhqd', a.astype(v.dtype), vb))
    return jnp.concatenate(outs, axis=2)


def differential_attention(q1, q2, k1, k2, v, lam):
    seq_len = q1.shape[2]
    scale = DIFF_QK_DIM ** -0.5
    outs = []
    for blk in range(seq_len // Q_BLOCK):
        q0 = blk * Q_BLOCK
        kv_len = q0 + Q_BLOCK
        qpos = q0 + jnp.arange(Q_BLOCK)[:, None]
        kpos = jnp.arange(kv_len)[None, :]
        causal = kpos <= qpos

        def probs(qx, kx):
            s = jnp.einsum('bhqd,bhkd->bhqk', qx[:, :, q0:kv_len], kx[:, :, :kv_len],
                           preferred_element_type=jnp.float32) * scale
            return jax.nn.softmax(jnp.where(causal, s, -jnp.inf), axis=-1)

        p = probs(q1, k1) - lam.astype(jnp.float32) * probs(q2, k2)
        outs.append(jnp.einsum('bhqk,bhkd->bhqd', p.astype(v.dtype), v[:, :, :kv_len]))
    return jnp.concatenate(outs, axis=2)


def hierarchical_moe(h, w_rg, b_rg, w_re, b_re, w_gate, w_up, w_down):
    b, s, d = h.shape
    n_tok = b * s
    t = h.reshape(n_tok, d)
    g_logits = (t @ w_rg + b_rg).astype(jnp.float32)
    grp = jnp.argmax(g_logits, axis=-1)
    p_grp = jnp.take_along_axis(jax.nn.softmax(g_logits, axis=-1), grp[:, None], axis=-1)
    e_logits = (t @ w_re + b_re).astype(jnp.float32).reshape(n_tok, N_GROUPS, EXPERTS_PER_GROUP)
    e_in = jnp.take_along_axis(e_logits, grp[:, None, None], axis=1)[:, 0]
    top_w, top_i = lax.top_k(jax.nn.softmax(e_in, axis=-1), TOP_K)
    top_w = top_w / jnp.sum(top_w, axis=-1, keepdims=True) * p_grp
    expert_id = grp[:, None] * EXPERTS_PER_GROUP + top_i

    n_assign = n_tok * TOP_K
    flat_e = expert_id.reshape(n_assign)
    flat_w = top_w.reshape(n_assign)
    flat_tok = jnp.arange(n_assign) // TOP_K
    order = jnp.argsort(flat_e)
    s_e, s_tok, s_w = flat_e[order], flat_tok[order], flat_w[order]
    counts = jnp.bincount(flat_e, length=N_EXPERTS)
    starts = jnp.cumsum(counts) - counts
    padded = (counts + EXPERT_BLOCK - 1) // EXPERT_BLOCK * EXPERT_BLOCK
    pad_end = jnp.cumsum(padded)
    pad_start = pad_end - padded
    dest = pad_start[s_e] + (jnp.arange(n_assign) - starts[s_e])
    n_rows = ((n_assign + EXPERT_BLOCK - 1) // EXPERT_BLOCK + N_EXPERTS) * EXPERT_BLOCK
    n_blocks = n_rows // EXPERT_BLOCK
    xd = jnp.zeros((n_rows, d), t.dtype).at[dest].set(t[s_tok])
    block_e = jnp.clip(jnp.searchsorted(pad_end, jnp.arange(n_blocks) * EXPERT_BLOCK, side='right'),
                       0, N_EXPERTS - 1)

    def expert_block(args):
        xb, e = args
        return (jax.nn.silu(xb @ w_gate[e]) * (xb @ w_up[e])) @ w_down[e]

    yd = lax.map(expert_block, (xd.reshape(n_blocks, EXPERT_BLOCK, d), block_e)).reshape(n_rows, d)
    y_assign = yd[dest] * s_w.astype(yd.dtype)[:, None]
    y = jax.ops.segment_sum(y_assign, s_tok, num_segments=n_tok)
    return y.reshape(b, s, d)


def setup_inputs(seed: int = 0) -> dict:
    key = jax.random.key(seed)
    ks = jax.random.split(key, 21)
    f32 = jnp.float32

    def normal(k, shape, scale):
        return jax.random.normal(k, shape, f32) * scale

    def gain(k, shape):
        return 1.0 + 0.02 * jax.random.normal(k, shape, f32)

    return {
        "x": normal(ks[0], (BATCH, SEQ, D_MODEL), 1.0),
        "g_norm_mix": gain(ks[1], (DEPTH, D_MODEL)),
        "w_in": normal(ks[2], (DEPTH, D_MODEL, IN_WIDTH), D_MODEL ** -0.5),
        "lambda_q1": normal(ks[3], (DEPTH, DIFF_QK_DIM), 0.1),
        "lambda_k1": normal(ks[4], (DEPTH, DIFF_QK_DIM), 0.1),
        "lambda_q2": normal(ks[5], (DEPTH, DIFF_QK_DIM), 0.1),
        "lambda_k2": normal(ks[6], (DEPTH, DIFF_QK_DIM), 0.1),
        "g_subln": gain(ks[7], (DEPTH, DIFF_V_DIM)),
        "w_up_a": normal(ks[8], (DEPTH, SB_WIDTH, D_MODEL), SB_WIDTH ** -0.5),
        "w_up_b": normal(ks[9], (DEPTH, DIFF_V_WIDTH, D_MODEL), DIFF_V_WIDTH ** -0.5),
        "w_out": normal(ks[10], (DEPTH, D_MODEL, D_MODEL), D_MODEL ** -0.5),
        "g_norm_ffn": gain(ks[11], (DEPTH, D_MODEL)),
        "w_router_group": normal(ks[12], (DEPTH, D_MODEL, N_GROUPS), D_MODEL ** -0.5),
        "b_router_group": normal(ks[13], (DEPTH, N_GROUPS), 0.01),
        "w_router_expert": normal(ks[14], (DEPTH, D_MODEL, N_EXPERTS), D_MODEL ** -0.5),
        "b_router_expert": normal(ks[15], (DEPTH, N_EXPERTS), 0.01),
        "w_expert_gate": normal(ks[16], (DEPTH, N_EXPERTS, D_MODEL, D_EXPERT), D_MODEL ** -0.5),
        "w_expert_up": normal(ks[17], (DEPTH, N_EXPERTS, D_MODEL, D_EXPERT), D_MODEL ** -0.5),
        "w_expert_down": normal(ks[18], (DEPTH, N_EXPERTS, D_EXPERT, D_MODEL), D_EXPERT ** -0.5),
        "g_norm_final": gain(ks[19], (D_MODEL,)),
    }


def reference(x, g_norm_mix, w_in, lambda_q1, lambda_k1, lambda_q2, lambda_k2, g_subln,
              w_up_a, w_up_b, w_out, g_norm_ffn, w_router_group, b_router_group,
              w_router_expert, b_router_expert, w_expert_gate, w_expert_up, w_expert_down,
              g_norm_final):
    b, s, _ = x.shape
    cos, sin = rope_tables(s, DIFF_QK_DIM)
    for l in range(DEPTH):
        h = rmsnorm(x, g_norm_mix[l])
        proj = jnp.einsum('bsd,de->bse', h, w_in[l])
        pieces = []
        off = 0
        for width in IN_SPLITS:
            pieces.append(proj[..., off:off + width])
            off += width
        sb_q, sb_k, sb_v, d_q, d_k, d_v, gate_a, gate_b = pieces

        o_a = stick_breaking_attention(split_heads(sb_q, SB_HEADS, HEAD_DIM),
                                       split_heads(sb_k, SB_HEADS, HEAD_DIM),
                                       split_heads(sb_v, SB_HEADS, HEAD_DIM))

        dq = d_q.reshape(b, s, DIFF_HEADS, 2, DIFF_QK_DIM).transpose(0, 2, 3, 1, 4)
        dk = d_k.reshape(b, s, DIFF_HEADS, 2, DIFF_QK_DIM).transpose(0, 2, 3, 1, 4)
        q1, q2 = apply_rope(dq[:, :, 0], cos, sin), apply_rope(dq[:, :, 1], cos, sin)
        k1, k2 = apply_rope(dk[:, :, 0], cos, sin), apply_rope(dk[:, :, 1], cos, sin)
        dv = split_heads(d_v, DIFF_HEADS, DIFF_V_DIM)
        lambda_init = 0.8 - 0.6 * math.exp(-0.3 * l)
        lam = (jnp.exp(jnp.sum(lambda_q1[l] * lambda_k1[l]))
               - jnp.exp(jnp.sum(lambda_q2[l] * lambda_k2[l])) + lambda_init)
        o_b = differential_attention(q1, q2, k1, k2, dv, lam)
        o_b = rmsnorm(o_b, g_subln[l]) * (1.0 - lambda_init)

        u_a = merge_heads(o_a) @ w_up_a[l]
        u_b = merge_heads(o_b) @ w_up_b[l]
        y = jax.nn.sigmoid(gate_a) * u_a + jax.nn.sigmoid(gate_b) * u_b
        x = x + y @ w_out[l]

        h2 = rmsnorm(x, g_norm_ffn[l])
        x = x + hierarchical_moe(h2, w_router_group[l], b_router_group[l],
                                 w_router_expert[l], b_router_expert[l],
                                 w_expert_gate[l], w_expert_up[l], w_expert_down[l])
    return rmsnorm(x, g_norm_final)
```

```cpp
#include <hip/hip_runtime.h>
#include <cstdio>
#include <cstdint>

#define GAS __attribute__((address_space(1)))
#define LAS __attribute__((address_space(3)))
typedef unsigned short bf16;
typedef short bf16x8 __attribute__((ext_vector_type(8)));
typedef short s16x4 __attribute__((ext_vector_type(4)));
typedef short v4i16_t __attribute__((ext_vector_type(4)));
typedef float f32x2 __attribute__((ext_vector_type(2)));
typedef float f32x4 __attribute__((ext_vector_type(4)));
typedef float f32x16 __attribute__((ext_vector_type(16)));
typedef unsigned u32x2 __attribute__((ext_vector_type(2)));
typedef unsigned u32x4 __attribute__((ext_vector_type(4)));
typedef __bf16 bf16x2_t __attribute__((ext_vector_type(2)));
typedef GAS unsigned gu32;

constexpr int M = 32768, DM = 1024, SEQ = 4096, NBATCH = 8;
constexpr int IN_W = 5120;
constexpr int NEXP = 32, DEXP = 256;
constexpr int NWAVES = 8, NTHREADS = 512;
constexpr float EPS = 1e-6f;
constexpr float LOG2E = 1.4426950408889634f;
constexpr float C2 = 0.125f * 1.4426950408889634f;
constexpr float SB_STOP = 152.0f;

constexpr size_t MiB = 1u << 20;
constexpr size_t WS_CTL = 0, CTL_ZERO_BYTES = 1 * MiB;
constexpr size_t WS_ROPE = 1 * MiB;
constexpr size_t WS_WIN = 2 * MiB;
constexpr size_t WS_WUPA = 12 * MiB, WS_WUPB = 13 * MiB;
constexpr size_t WS_WOUT = 14 * MiB;
constexpr size_t WS_WGU = 16 * MiB;
constexpr size_t WS_WDN = 48 * MiB;
constexpr size_t WS_XN = 64 * MiB;
constexpr size_t WS_SBQ = 128 * MiB;
constexpr size_t WS_SMALL_STRIDE = 32 * MiB;
constexpr size_t WS_GA = 320 * MiB, WS_GB = 384 * MiB;
constexpr size_t WS_HID = 160 * MiB;
constexpr size_t WS_LTOK = 256 * MiB, WS_LW = 260 * MiB;
constexpr size_t WS_YA = 320 * MiB;
constexpr size_t WS_END = 448 * MiB;
constexpr int LCAP = 32768;

constexpr int CW_TMO = 0;
constexpr int CW_BAR = 4096;
constexpr int CW_CNT = 16384;

constexpr int LDS_BYTES = 163840;
constexpr int MISC_OFF = LDS_BYTES - 256;
constexpr int SCHED_OFF = 131072;

#define RLX_AGENT __ATOMIC_RELAXED, __HIP_MEMORY_SCOPE_AGENT
__device__ __forceinline__ unsigned cvtpk(float lo, float hi) { f32x2 v = {lo, hi}; bf16x2_t b = __builtin_convertvector(v, bf16x2_t); return __builtin_bit_cast(unsigned, b); }
__device__ __forceinline__ float bf_lo(unsigned w) { return __uint_as_float(w << 16); }
__device__ __forceinline__ float bf_hi(unsigned w) { return __uint_as_float(w & 0xffff0000u); }
__device__ __forceinline__ float wave_sum(float v) {
#pragma unroll
    for (int o = 1; o < 64; o <<= 1) v += __shfl_xor(v, o);
    return v;
}
__device__ __forceinline__ float ex2(float x) { return __builtin_amdgcn_exp2f(x); }
__device__ __forceinline__ float lg2(float x) { return __builtin_amdgcn_logf(x); }
__device__ __forceinline__ float sigmoidf_(float x) { return __builtin_amdgcn_rcpf(1.0f + ex2(-x * LOG2E)); }
__device__ __forceinline__ int crow(int r, int hi) { return (r & 3) + 8 * (r >> 2) + 4 * hi; }
#define MFMA32(a, b, c) __builtin_amdgcn_mfma_f32_32x32x16_bf16(a, b, c, 0, 0, 0)

#define XB_TMO      128
#define XB_XCNT(j)  (256  + 64 * (j))
#define XB_XSUB(j)  (1280 + 64 * (j))
#define XB_XGEN(j)  (2304 + 64 * (j))
#define XB_TOP      3328
#define XB_TOPGEN   3392
#define XCD_BAR_WORDS 3456
#define XB_SPIN_CAP (1u << 18)
__device__ __forceinline__ unsigned xb_ld(unsigned* p)              { return __hip_atomic_load(p, __ATOMIC_RELAXED, __HIP_MEMORY_SCOPE_AGENT); }
__device__ __forceinline__ unsigned xb_add(unsigned* p, unsigned v) { return __hip_atomic_fetch_add(p, v, __ATOMIC_RELAXED, __HIP_MEMORY_SCOPE_AGENT); }
__device__ __forceinline__ unsigned xb_xcc_id() { return (unsigned)__builtin_amdgcn_s_getreg((3 << 11) | 20) & 0xFu; }
#define XB_SPIN(cond, bar) do { unsigned _sp = 0; while (cond) { __builtin_amdgcn_s_sleep(1); \
    if ((++_sp & 255u) == 0u) { if (xb_ld(&(bar)[XB_TMO])) break; if (_sp > XB_SPIN_CAP) { atomicAdd(&(bar)[XB_TMO], 1u); break; } } } } while (0)
struct XcdBarrier { unsigned* bar; unsigned x; volatile LAS unsigned* st; };
__device__ __forceinline__ XcdBarrier xcd_barrier_post(unsigned* bar, volatile LAS unsigned* st) {
    XcdBarrier b; b.bar = bar; b.x = xb_xcc_id(); b.st = st;
    if (threadIdx.x == 0) (void)xb_add(&bar[XB_XCNT(b.x)], 1u);
    return b;
}
__device__ __forceinline__ void xcd_barrier_complete(unsigned* bar, unsigned x, unsigned& nloc, unsigned& nx) {
    const unsigned G = gridDim.x * gridDim.y * gridDim.z;
    unsigned sum, cnt, mine, sp = 0u;
    for (;;) {
        sum = 0u; cnt = 0u; mine = 0u;
#pragma unroll
        for (unsigned j = 0; j < 16; ++j) { const unsigned c = xb_ld(&bar[XB_XCNT(j)]); sum += c; cnt += (c > 0u) ? 1u : 0u; mine = (j == x) ? c : mine; }
        if (sum == G) break;
        __builtin_amdgcn_s_sleep(1);
        if ((++sp & 255u) == 0u) { if (xb_ld(&bar[XB_TMO])) break; if (sp > XB_SPIN_CAP) { atomicAdd(&bar[XB_TMO], 1u); break; } }
    }
    nloc = mine > 0u ? mine : 1u; nx = cnt > 0u ? cnt : 1u;
}
__device__ __forceinline__ void xcd_barrier(const XcdBarrier& b) {
    asm volatile("s_waitcnt vmcnt(0)" ::: "memory");
    __syncthreads();
    if (threadIdx.x == 0) {
        unsigned* bar = b.bar;
        __builtin_amdgcn_s_waitcnt(0);
        unsigned nloc = b.st[0], nx = b.st[1];
        if (nloc == 0u) { xcd_barrier_complete(bar, b.x, nloc, nx); b.st[0] = nloc; b.st[1] = nx; }
        const unsigned old = xb_add(&bar[XB_XSUB(b.x)], 1u);
        const unsigned gen = old / nloc;
        if (old + 1u == (gen + 1u) * nloc) {
            __builtin_amdgcn_fence(__ATOMIC_RELEASE, "agent");
            asm volatile("s_waitcnt vmcnt(0)" ::: "memory");
            const unsigned og = xb_add(&bar[XB_TOP], 1u);
            const unsigned tg = og / nx;
            if (og + 1u == (tg + 1u) * nx) xb_add(&bar[XB_TOPGEN], 1u);
            else XB_SPIN(xb_ld(&bar[XB_TOPGEN]) == tg, bar);
            __builtin_amdgcn_fence(__ATOMIC_ACQUIRE, "agent");
            xb_add(&bar[XB_XGEN(b.x)], 1u);
            asm volatile("s_waitcnt vmcnt(0)" ::: "memory");
        } else {
            XB_SPIN(xb_ld(&bar[XB_XGEN(b.x)]) == gen, bar);
            __builtin_amdgcn_fence(__ATOMIC_ACQUIRE, "agent");
            asm volatile("s_waitcnt vmcnt(0)" ::: "memory");
        }
    }
    __syncthreads();
}

namespace pg8 {
constexpr int BM = 256, BK = 64, HALF = 128, HTB = HALF * BK * 2, STAGE_BYTES = 8 * HTB, NXCD = 8, WGM = 8;
__host__ __device__ __forceinline__ int lds_byte(int r, int c) { const int st = (r >> 4) * 2 + (c >> 5), rr = r & 15, cc = c & 31, ob = rr * 64 + cc * 2; return st * 1024 + (ob ^ (((ob >> 9) & 1) << 5)); }
__host__ __device__ __forceinline__ void stage_rc(int b, int& R, int& C) { const int st = b / 1024, sb = b % 1024, swz = sb ^ (((sb >> 9) & 1) << 5); R = (st >> 1) * 16 + swz / 64; C = (st & 1) * 32 + (swz % 64) / 2; }
__host__ __device__ __forceinline__ int perm32(int rho) { const int n = rho >> 4, i = rho & 15; return 8 * (i >> 2) + 4 * n + (i & 3); }

struct Unit { int pm, pn, e, t, cnt, slot0; };

struct TileOrder {
    int nM, nN, nwg, G, c;
    __device__ void init(int M_, int N_, int G_, int c_) { nM = M_ / BM; nN = N_ / BM; nwg = nM * nN; G = G_; c = c_; }
    __device__ bool tile(int i, int& pm, int& pn) const {
        const long L = (long)i * G + c; if (L >= nwg) return false;
        int wgid = (int)L; { const int q = nwg / NXCD, r = nwg % NXCD, xcd = wgid % NXCD, off = wgid / NXCD; wgid = (xcd < r ? xcd * (q + 1) : r * (q + 1) + (xcd - r) * q) + off; }
        const int nig = WGM * nN, gid = wgid / nig, fm = gid * WGM, gsz = (nM - fm) < WGM ? (nM - fm) : WGM;
        pm = fm + ((wgid % nig) % gsz); pn = (wgid % nig) / gsz; return true;
    }
};

template <class Epi, class Sched, bool ALIGN_EPI>
__device__ __forceinline__ void gemm_phase(LAS unsigned char* lds, const int K, const Sched& S, const Epi& E) {
    const int tid = threadIdx.x, wid = __builtin_amdgcn_readfirstlane(tid >> 6), lane = tid & 63, wr = wid >> 2, wc = wid & 3, fr = lane & 15, fq = lane >> 4;
    const int nt = K / BK;
    int Rr[2], Cc[2]; unsigned voffB[2];
#pragma unroll
    for (int i = 0; i < 2; ++i) { int R, C; stage_rc(tid * 16 + i * 8192, R, C); Rr[i] = R; Cc[i] = C; const int Rb = Epi::PERM ? ((R & ~31) + perm32(R & 31)) : R; voffB[i] = (unsigned)(Rb * K + C) * 2u; }
    const size_t kstep = (size_t)(BK * 2);
    const size_t hstep = (size_t)HALF * K * 2;
    const unsigned ldsw = (unsigned)wid * 1024u;
    const int aoff = lds_byte(wr * 64 + fr, fq * 8), boff = lds_byte(wc * 32 + fr, fq * 8);
#define PG8_SA(b, h) (((b) * 2 + (h)) * HTB)
#define PG8_SB(b, h) ((4 + (b) * 2 + (h)) * HTB)
#define PG8_STAGE2(bufoff, gbase, v0, v1) do { \
        __builtin_amdgcn_global_load_lds((const unsigned*)((const char*)(gbase) + (v0)), (LAS unsigned*)(lds + (bufoff) + ldsw), 16, 0, 0); \
        __builtin_amdgcn_global_load_lds((const unsigned*)((const char*)(gbase) + (v1)), (LAS unsigned*)(lds + (bufoff) + ldsw + 8192), 16, 0, 0); } while (0)
#define PG8_STAGEB(bufoff, gbase) PG8_STAGE2(bufoff, gbase, voffB[0], voffB[1])
#define PG8_LDA(dst, b, h) do { _Pragma("unroll") for (int m = 0; m < 4; ++m) _Pragma("unroll") for (int k = 0; k < 2; ++k) dst[m][k] = *(const LAS bf16x8*)(lds + PG8_SA(b, h) + aoff + m * 2048 + k * 1024); } while (0)
#define PG8_LDB(dst, b, h) do { _Pragma("unroll") for (int n = 0; n < 2; ++n) _Pragma("unroll") for (int k = 0; k < 2; ++k) dst[n][k] = *(const LAS bf16x8*)(lds + PG8_SB(b, h) + boff + n * 2048 + k * 1024); } while (0)
#define PG8_MMA(ai, bj, At, Bt) do { __builtin_amdgcn_s_setprio(1); _Pragma("unroll") for (int m = 0; m < 4; ++m) _Pragma("unroll") for (int n = 0; n < 2; ++n) _Pragma("unroll") for (int k = 0; k < 2; ++k) \
        acc[ai][bj][m][n] = __builtin_amdgcn_mfma_f32_16x16x32_bf16(Bt[n][k], At[m][k], acc[ai][bj][m][n], 0, 0, 0); __builtin_amdgcn_s_setprio(0); } while (0)
#define PG8_WAIT_V(n) asm volatile("s_waitcnt vmcnt(" #n ")" ::: "memory")
#define PG8_WAIT_L(n) asm volatile("s_waitcnt lgkmcnt(" #n ")" ::: "memory")
#define PG8_BAR __builtin_amdgcn_s_barrier()
#define PG8_SCHED __builtin_amdgcn_sched_barrier(0)
    Unit cur, nxt; int ui = 0;
    if (!S.next(0, cur)) return;
    f32x4 acc[2][2][4][2];
#pragma unroll
    for (int a = 0; a < 2; ++a)
#pragma unroll
        for (int b = 0; b < 2; ++b)
#pragma unroll
            for (int m = 0; m < 4; ++m)
#pragma unroll
                for (int n = 0; n < 2; ++n) acc[a][b][m][n] = (f32x4){0.f, 0.f, 0.f, 0.f};
    bf16x8 At[4][2], B0[2][2], B1[2][2];
    const char* cA = S.a_ptr(cur); const char* cB = S.b_ptr(cur);
    unsigned vA00 = S.a_off(cur, Rr[0]) + (unsigned)Cc[0] * 2u, vA01 = S.a_off(cur, Rr[1]) + (unsigned)Cc[1] * 2u;
    unsigned vA10 = S.a_off(cur, HALF + Rr[0]) + (unsigned)Cc[0] * 2u, vA11 = S.a_off(cur, HALF + Rr[1]) + (unsigned)Cc[1] * 2u;
    PG8_STAGEB(PG8_SB(0, 0), cB); PG8_STAGEB(PG8_SB(0, 1), cB + hstep); PG8_STAGE2(PG8_SA(0, 0), cA, vA00, vA01); PG8_STAGE2(PG8_SA(0, 1), cA, vA10, vA11);
    if (wr == 1) PG8_BAR;
    PG8_WAIT_V(2); PG8_BAR;
    PG8_STAGEB(PG8_SB(1, 0), cB + kstep); PG8_STAGE2(PG8_SA(1, 0), cA + kstep, vA00, vA01); PG8_STAGEB(PG8_SB(1, 1), cB + hstep + kstep);
    PG8_WAIT_V(6); PG8_BAR;
    for (;;) {
        const bool has_next = S.next(ui + 1, nxt);
        const char* nA = has_next ? S.a_ptr(nxt) : cA; const char* nB = has_next ? S.b_ptr(nxt) : cB;
        unsigned nA00 = vA00, nA01 = vA01, nA10 = vA10, nA11 = vA11;
        if (has_next) { nA00 = S.a_off(nxt, Rr[0]) + (unsigned)Cc[0] * 2u; nA01 = S.a_off(nxt, Rr[1]) + (unsigned)Cc[1] * 2u;
                        nA10 = S.a_off(nxt, HALF + Rr[0]) + (unsigned)Cc[0] * 2u; nA11 = S.a_off(nxt, HALF + Rr[1]) + (unsigned)Cc[1] * 2u; }
        for (int t = 0; t < nt; t += 2) {
            const bool last = (t == nt - 2);
            const char* a1 = cA + (size_t)(t + 1) * kstep;
            const char* a2 = last ? nA : cA + (size_t)(t + 2) * kstep; const char* b2 = last ? nB : cB + (size_t)(t + 2) * kstep;
            const char* a3 = a2 + kstep; const char* b3 = b2 + kstep;
            const unsigned w00 = last ? nA00 : vA00, w01 = last ? nA01 : vA01, w10 = last ? nA10 : vA10, w11 = last ? nA11 : vA11;
            PG8_LDB(B0, 0, 0); PG8_LDB(B1, 0, 1); PG8_SCHED; PG8_LDA(At, 0, 0); PG8_STAGE2(PG8_SA(1, 1), a1, vA10, vA11);
            PG8_WAIT_V(8); PG8_WAIT_L(0); PG8_BAR; PG8_MMA(0, 0, At, B0); PG8_MMA(0, 1, At, B1); PG8_BAR; PG8_SCHED;
            PG8_LDA(At, 0, 1); PG8_STAGEB(PG8_SB(0, 0), b2); PG8_STAGEB(PG8_SB(0, 1), b2 + hstep); PG8_STAGE2(PG8_SA(0, 0), a2, w00, w01);
            PG8_WAIT_V(8); PG8_WAIT_L(0); PG8_BAR; PG8_MMA(1, 0, At, B0); PG8_MMA(1, 1, At, B1); PG8_BAR; PG8_SCHED;
            PG8_LDB(B0, 1, 0); PG8_LDB(B1, 1, 1); PG8_SCHED; PG8_LDA(At, 1, 0); PG8_STAGE2(PG8_SA(0, 1), a2, w10, w11);
            PG8_WAIT_V(8); PG8_WAIT_L(0); PG8_BAR; PG8_MMA(0, 0, At, B0); PG8_MMA(0, 1, At, B1); PG8_BAR; PG8_SCHED;
            PG8_LDA(At, 1, 1); PG8_STAGEB(PG8_SB(1, 0), b3); PG8_STAGEB(PG8_SB(1, 1), b3 + hstep); PG8_STAGE2(PG8_SA(1, 0), a3, w00, w01);
            PG8_WAIT_V(8); PG8_WAIT_L(0); PG8_BAR; PG8_MMA(1, 0, At, B0); PG8_MMA(1, 1, At, B1); PG8_BAR; PG8_SCHED;
        }
        if constexpr (ALIGN_EPI) { if (wr == 0) PG8_BAR; }
        const bool zero = E(acc, cur, wr, wc, fr, fq);
        if (!has_next) break;
        if (zero) {
#pragma unroll
        for (int a = 0; a < 2; ++a)
#pragma unroll
            for (int b = 0; b < 2; ++b)
#pragma unroll
                for (int m = 0; m < 4; ++m)
#pragma unroll
                    for (int n = 0; n < 2; ++n) acc[a][b][m][n] = (f32x4){0.f, 0.f, 0.f, 0.f};
        }
        cur = nxt; cA = nA; cB = nB; ++ui; vA00 = nA00; vA01 = nA01; vA10 = nA10; vA11 = nA11;
        if constexpr (ALIGN_EPI) { if (wr == 1) PG8_BAR; }
    }
    PG8_WAIT_V(0);
    if constexpr (!ALIGN_EPI) { if (wr == 0) PG8_BAR; }
    PG8_BAR;
#undef PG8_SA
#undef PG8_SB
#undef PG8_STAGE2
#undef PG8_STAGEB
#undef PG8_LDA
#undef PG8_LDB
#undef PG8_MMA
#undef PG8_WAIT_V
#undef PG8_WAIT_L
#undef PG8_BAR
#undef PG8_SCHED
}
}
using pg8::Unit;

struct SchedDense {
    pg8::TileOrder T; const char* A; const char* B; int K;
    __device__ __forceinline__ bool next(int i, Unit& u) const { u.e = 0; u.t = 0; u.cnt = 0; u.slot0 = 0; return T.tile(i, u.pm, u.pn); }
    __device__ __forceinline__ const char* a_ptr(const Unit& u) const { return A + (size_t)u.pm * 256 * K * 2; }
    __device__ __forceinline__ const char* b_ptr(const Unit& u) const { return B + (size_t)u.pn * 256 * K * 2; }
    __device__ __forceinline__ unsigned a_off(const Unit&, int row) const { return (unsigned)(row * K) * 2u; }
};
struct EpiInProj {
    static constexpr bool PERM = true;
    unsigned char* ws; const f32x4* rope;
    __device__ __forceinline__ bool operator()(const f32x4 (&acc)[2][2][4][2], const Unit& u, int wr, int wc, int fr, int fq) const {
        const int pn = u.pn; bf16* base; int ld, colt;
        if (pn < 12) { base = (bf16*)(ws + WS_SBQ + (size_t)(pn >> 1) * WS_SMALL_STRIDE); ld = 512; colt = (pn & 1) * 256; }
        else { base = (bf16*)(ws + WS_GA + (size_t)((pn - 12) >> 2) * (WS_GB - WS_GA)); ld = 1024; colt = ((pn - 12) & 3) * 256; }
        const float sc = (pn < 2 || pn == 6 || pn == 7) ? C2 : 1.0f;
        const bool rp = (pn >= 6 && pn < 10);
        const int row0 = u.pm * 256 + wr * 64 + fr, col0 = colt + wc * 32 + 8 * fq;
#pragma unroll
        for (int ai = 0; ai < 2; ++ai)
#pragma unroll
            for (int m = 0; m < 4; ++m) {
                const int row = row0 + ai * 128 + m * 16; bf16* rowp = base + (size_t)row * ld + col0;
#pragma unroll
                for (int bj = 0; bj < 2; ++bj) {
                    f32x4 v0 = acc[ai][bj][m][0], v1 = acc[ai][bj][m][1];
                    if (rp) {
                        const int i0 = ((col0 + bj * 128) & 63) >> 1;
                        const f32x4* rt = rope + (size_t)(row & (SEQ - 1)) * 16 + (i0 >> 1);
                        const f32x4 cs0 = rt[0], cs1 = rt[1];
                        f32x4 w0, w1;
                        w0[0] = v0[0] * cs0[0] - v0[1] * cs0[1]; w0[1] = v0[1] * cs0[0] + v0[0] * cs0[1];
                        w0[2] = v0[2] * cs0[2] - v0[3] * cs0[3]; w0[3] = v0[3] * cs0[2] + v0[2] * cs0[3];
                        w1[0] = v1[0] * cs1[0] - v1[1] * cs1[1]; w1[1] = v1[1] * cs1[0] + v1[0] * cs1[1];
                        w1[2] = v1[2] * cs1[2] - v1[3] * cs1[3]; w1[3] = v1[3] * cs1[2] + v1[2] * cs1[3];
                        v0 = w0; v1 = w1;
                    }
                    v0 = v0 * sc; v1 = v1 * sc;
                    u32x4 w; w.x = cvtpk(v0[0], v0[1]); w.y = cvtpk(v0[2], v0[3]); w.z = cvtpk(v1[0], v1[1]); w.w = cvtpk(v1[2], v1[3]);
                    *(u32x4*)(rowp + bj * 128) = w;
                }
            }
        return true;
    }
};

struct SchedUp {
    pg8::TileOrder T; const char* OA; const char* OB; const char* WA; const char* WB;
    __device__ __forceinline__ bool next(int i, Unit& u) const { u.e = i & 1; u.t = 0; u.cnt = 0; u.slot0 = 0; return T.tile(i >> 1, u.pm, u.pn); }
    __device__ __forceinline__ const char* a_ptr(const Unit& u) const { return (u.e ? OB : OA) + (size_t)u.pm * 256 * 512 * 2; }
    __device__ __forceinline__ const char* b_ptr(const Unit& u) const { return (u.e ? WB : WA) + (size_t)u.pn * 256 * 512 * 2; }
    __device__ __forceinline__ unsigned a_off(const Unit&, int row) const { return (unsigned)(row * 512) * 2u; }
};
struct EpiUp {
    static constexpr bool PERM = true;
    const bf16* GA; const bf16* GB; bf16* Y;
    __device__ __forceinline__ bool operator()(f32x4 (&acc)[2][2][4][2], const Unit& u, int wr, int wc, int fr, int fq) const {
        const int row0 = u.pm * 256 + wr * 64 + fr, col0 = u.pn * 256 + wc * 32 + 8 * fq;
        const bool fin = (u.e != 0);
#pragma unroll
        for (int ai = 0; ai < 2; ++ai)
#pragma unroll
            for (int m = 0; m < 4; ++m) {
                const size_t off = (size_t)(row0 + ai * 128 + m * 16) * 1024 + col0;
#pragma unroll
                for (int bj = 0; bj < 2; ++bj) {
                    const u32x4 gbw = *(const u32x4*)(GB + off + bj * 128);
                    float eb[8];
#pragma unroll
                    for (int j = 0; j < 4; ++j) { const float g0 = fmaxf(bf_lo(gbw[j]), -60.f), g1 = fmaxf(bf_hi(gbw[j]), -60.f); eb[2 * j] = 1.0f + ex2(-g0 * LOG2E); eb[2 * j + 1] = 1.0f + ex2(-g1 * LOG2E); }
                    if (!fin) {
                        const u32x4 gaw = *(const u32x4*)(GA + off + bj * 128);
#pragma unroll
                        for (int j = 0; j < 4; ++j) {
                            const float ea0 = 1.0f + ex2(-bf_lo(gaw[j]) * LOG2E), ea1 = 1.0f + ex2(-bf_hi(gaw[j]) * LOG2E);
                            const float r0 = eb[2 * j] * __builtin_amdgcn_rcpf(ea0), r1 = eb[2 * j + 1] * __builtin_amdgcn_rcpf(ea1);
                            if (j < 2) { acc[ai][bj][m][0][2 * j] *= r0; acc[ai][bj][m][0][2 * j + 1] *= r1; }
                            else { acc[ai][bj][m][1][2 * (j - 2)] *= r0; acc[ai][bj][m][1][2 * (j - 2) + 1] *= r1; }
                        }
                    } else {
                        float o[8];
#pragma unroll
                        for (int j = 0; j < 8; ++j) { const float a = (j < 4) ? acc[ai][bj][m][0][j] : acc[ai][bj][m][1][j - 4]; o[j] = a * __builtin_amdgcn_rcpf(eb[j]); }
                        u32x4 w; w.x = cvtpk(o[0], o[1]); w.y = cvtpk(o[2], o[3]); w.z = cvtpk(o[4], o[5]); w.w = cvtpk(o[6], o[7]);
                        *(u32x4*)(Y + off + bj * 128) = w;
                    }
                }
            }
        return fin;
    }
};

struct EpiOut {
    static constexpr bool PERM = false;
    const float* X; float* O;
    __device__ __forceinline__ bool operator()(const f32x4 (&acc)[2][2][4][2], const Unit& u, int wr, int wc, int fr, int fq) const {
        const int row0 = u.pm * 256 + wr * 64 + fr, col0 = u.pn * 256 + wc * 32 + 4 * fq;
#pragma unroll
        for (int ai = 0; ai < 2; ++ai)
#pragma unroll
            for (int m = 0; m < 4; ++m) {
                const size_t off = (size_t)(row0 + ai * 128 + m * 16) * 1024 + col0;
#pragma unroll
                for (int bj = 0; bj < 2; ++bj)
#pragma unroll
                    for (int n = 0; n < 2; ++n) { const f32x4 xv = *(const f32x4*)(X + off + bj * 128 + n * 16); *(f32x4*)(O + off + bj * 128 + n * 16) = xv + acc[ai][bj][m][n]; }
            }
        return true;
    }
};

struct MoeTables { const LAS int* tstart; const LAS int* cnt; };
template <int NPN, bool GATHER>
struct SchedMoe {
    MoeTables tb; int G, c; const char* A; const char* B; const int* ltok; int K; size_t bstride_e;
    __device__ __forceinline__ bool next(int i, Unit& u) const {
        const int T = tb.tstart[NEXP]; const long L = (long)i * G + c; if (L >= (long)T * NPN) return false;
        const int rt = (int)(L / NPN); u.pn = (int)(L % NPN); int e = 0;
#pragma unroll 1
        for (int j = 1; j < NEXP; ++j) e = (tb.tstart[j] <= rt) ? j : e;
        u.e = e; u.t = rt - tb.tstart[e]; u.cnt = tb.cnt[e]; u.slot0 = rt * 256; u.pm = rt; return true;
    }
    __device__ __forceinline__ const char* a_ptr(const Unit& u) const { return GATHER ? A : A + (size_t)u.slot0 * K * 2; }
    __device__ __forceinline__ const char* b_ptr(const Unit& u) const { return B + (size_t)u.e * bstride_e + (size_t)u.pn * 256 * K * 2; }
    __device__ __forceinline__ unsigned a_off(const Unit& u, int row) const {
        if (GATHER) { int pos = u.t * 256 + row; pos = pos < u.cnt ? pos : u.cnt - 1; const int tok = ltok[(size_t)u.e * LCAP + pos] >> 1; return (unsigned)tok * (unsigned)(K * 2); }
        return (unsigned)(row * K) * 2u;
    }
};
struct EpiMoeGU {
    static constexpr bool PERM = true;
    bf16* HID;
    __device__ __forceinline__ bool operator()(const f32x4 (&acc)[2][2][4][2], const Unit& u, int wr, int wc, int fr, int fq) const {
        const int row0 = u.slot0 + wr * 64 + fr, col0 = u.pn * 128 + wc * 32 + 8 * fq;
#pragma unroll
        for (int ai = 0; ai < 2; ++ai)
#pragma unroll
            for (int m = 0; m < 4; ++m) {
                float o[8];
#pragma unroll
                for (int j = 0; j < 8; ++j) { const float g = (j < 4) ? acc[ai][0][m][0][j] : acc[ai][0][m][1][j - 4], up = (j < 4) ? acc[ai][1][m][0][j] : acc[ai][1][m][1][j - 4];
                    o[j] = g * sigmoidf_(g) * up; }
                u32x4 w; w.x = cvtpk(o[0], o[1]); w.y = cvtpk(o[2], o[3]); w.z = cvtpk(o[4], o[5]); w.w = cvtpk(o[6], o[7]);
                *(u32x4*)(HID + (size_t)(row0 + ai * 128 + m * 16) * 256 + col0) = w;
            }
        return true;
    }
};
struct EpiMoeDown {
    static constexpr bool PERM = true;
    bf16* YA; const int* ltok; const float* lw;
    __device__ __forceinline__ bool operator()(const f32x4 (&acc)[2][2][4][2], const Unit& u, int wr, int wc, int fr, int fq) const {
        const int col0 = u.pn * 256 + wc * 32 + 8 * fq;
        const int* lt = ltok + (size_t)u.e * LCAP; const float* lwp = lw + (size_t)u.e * LCAP;
        const int pos0 = u.t * 256 + wr * 64 + fr;
#pragma unroll
        for (int ai = 0; ai < 2; ++ai)
#pragma unroll
            for (int m = 0; m < 4; ++m) {
                const int pos = pos0 + ai * 128 + m * 16; const bool valid = pos < u.cnt; const int pc = valid ? pos : u.cnt - 1;
                int tok2 = lt[pc]; const float w8 = lwp[pc]; tok2 = valid ? tok2 : -1;
                bf16* rowp = YA + ((long)tok2 * 1024 + col0);
#pragma unroll
                for (int bj = 0; bj < 2; ++bj) { const f32x4 v0 = acc[ai][bj][m][0] * w8, v1 = acc[ai][bj][m][1] * w8;
                    u32x4 w; w.x = cvtpk(v0[0], v0[1]); w.y = cvtpk(v0[2], v0[3]); w.z = cvtpk(v1[0], v1[1]); w.w = cvtpk(v1[2], v1[3]);
                    *(u32x4*)(rowp + bj * 128) = w; }
                asm volatile("" ::: "memory");
            }
        return true;
    }
};

__device__ const double INV_FREQ[32] = {1.0, 0.7498942093324559, 0.5623413251903491, 0.4216965034285822, 0.31622776601683794, 0.23713737056616552, 0.1778279410038923, 0.1333521432163324, 0.1, 0.07498942093324558, 0.05623413251903491, 0.042169650342858224, 0.03162277660168379, 0.023713737056616554, 0.01778279410038923, 0.01333521432163324, 0.01, 0.007498942093324558, 0.005623413251903491, 0.004216965034285823, 0.0031622776601683794, 0.0023713737056616554, 0.0017782794100389228, 0.001333521432163324, 0.001, 0.0007498942093324559, 0.0005623413251903491, 0.00042169650342858224, 0.00031622776601683794, 0.00023713737056616554, 0.00017782794100389227, 0.0001333521432163324};
__device__ __forceinline__ void sincos_d(double a, float& c, float& s) {
    const double TWO_OVER_PI = 0.63661977236758134308, PIO2_HI = 1.57079632679489655800e+00, PIO2_LO = 6.12323399573676603587e-17;
    const double kd = __builtin_rint(a * TWO_OVER_PI); const int q = (int)((long long)kd & 3);
    const double r = (a - kd * PIO2_HI) - kd * PIO2_LO, r2 = r * r;
    double sp = -1.0 / 1307674368000.0; sp = sp * r2 + 1.0 / 6227020800.0; sp = sp * r2 - 1.0 / 39916800.0; sp = sp * r2 + 1.0 / 362880.0; sp = sp * r2 - 1.0 / 5040.0; sp = sp * r2 + 1.0 / 120.0; sp = sp * r2 - 1.0 / 6.0; sp = sp * r2 + 1.0;
    const double sr = sp * r;
    double cp = 1.0 / 20922789888000.0; cp = cp * r2 - 1.0 / 87178291200.0; cp = cp * r2 + 1.0 / 479001600.0; cp = cp * r2 - 1.0 / 3628800.0; cp = cp * r2 + 1.0 / 40320.0; cp = cp * r2 - 1.0 / 720.0; cp = cp * r2 + 1.0 / 24.0; cp = cp * r2 - 0.5; cp = cp * r2 + 1.0;
    const double cr = cp;
    double sv, cv;
    if (q == 0) { sv = sr; cv = cr; } else if (q == 1) { sv = cr; cv = -sr; } else if (q == 2) { sv = -sr; cv = -cr; } else { sv = -cr; cv = sr; }
    c = (float)cv; s = (float)sv;
}
__device__ __forceinline__ int map_in(int n) { if (n < 1536 || n >= 2560) return n; const int i = n & 63; return (n & ~63) + (i < 32 ? 2 * i : 2 * (i - 32) + 1); }
template <int MODE>
__device__ __forceinline__ void transpose_item(const float* W, int ldw, bf16* WT, int ldk, int k0, int n0, const float* kscale, float kmul, LAS float* scr, int lane) {
#pragma unroll 8
    for (int i = 0; i < 32; ++i) { const int kk = 2 * i + (lane >> 5); float v = W[(size_t)(k0 + kk) * ldw + n0 + (lane & 31)]; if (kscale) v *= kscale[(k0 + kk) & 127] * kmul; scr[kk * 33 + (lane & 31)] = v; }
    asm volatile("s_waitcnt lgkmcnt(0)" ::: "memory");
    const int c = lane & 7;
#pragma unroll
    for (int j = 0; j < 4; ++j) { const int n = (lane >> 3) + 8 * j; const LAS float* s = scr + (8 * c) * 33 + n;
        u32x4 o; o.x = cvtpk(s[0 * 33], s[1 * 33]); o.y = cvtpk(s[2 * 33], s[3 * 33]); o.z = cvtpk(s[4 * 33], s[5 * 33]); o.w = cvtpk(s[6 * 33], s[7 * 33]);
        const int nn = n0 + n; int dr;
        if (MODE == 0) dr = nn; else if (MODE == 1) dr = map_in(nn); else if (MODE == 2) dr = (nn >> 7) * 256 + (nn & 127); else dr = (nn >> 7) * 256 + 128 + (nn & 127);
        *(u32x4*)(WT + (size_t)dr * ldk + k0 + 8 * c) = o; }
    asm volatile("s_waitcnt lgkmcnt(0)" ::: "memory");
}
struct Ptrs {
    const float *x, *g_mix, *w_in, *lq1, *lk1, *lq2, *lk2, *g_sub, *w_upa, *w_upb, *w_out, *g_ffn, *w_rg, *b_rg, *w_re, *b_re, *w_eg, *w_eu, *w_ed, *g_fin;
    float* out; unsigned char* ws;
};
__device__ __forceinline__ void p0_prologue(const Ptrs& P, LAS unsigned char* lds, int vcu, int G, int wave, int lane) {
    LAS float* scr = (LAS float*)(lds + wave * 16384);
    const int gw = vcu * NWAVES + wave, NGW = G * NWAVES;
    unsigned char* ws = P.ws;
    constexpr int I_IN = 16 * 160, I_UP = 8 * 32, I_OUT = 16 * 32, I_EG = 16 * 8 * NEXP, I_ED = 4 * 32 * NEXP;
    constexpr int NITEMS = I_IN + 2 * I_UP + I_OUT + 2 * I_EG + I_ED;
    for (int it = gw; it < NITEMS; it += NGW) {
        int r = it;
        if (r < I_IN) { transpose_item<1>(P.w_in, IN_W, (bf16*)(ws + WS_WIN), 1024, (r / 160) * 64, (r % 160) * 32, nullptr, 1.f, scr, lane); continue; } r -= I_IN;
        if (r < I_UP) { transpose_item<0>(P.w_upa, 1024, (bf16*)(ws + WS_WUPA), 512, (r / 32) * 64, (r % 32) * 32, nullptr, 1.f, scr, lane); continue; } r -= I_UP;
        if (r < I_UP) { transpose_item<0>(P.w_upb, 1024, (bf16*)(ws + WS_WUPB), 512, (r / 32) * 64, (r % 32) * 32, P.g_sub, 0.8f, scr, lane); continue; } r -= I_UP;
        if (r < I_OUT) { transpose_item<0>(P.w_out, 1024, (bf16*)(ws + WS_WOUT), 1024, (r / 32) * 64, (r % 32) * 32, nullptr, 1.f, scr, lane); continue; } r -= I_OUT;
        if (r < I_EG) { const int e = r / 128, q = r % 128; transpose_item<2>(P.w_eg + (size_t)e * 1024 * 256, 256, (bf16*)(ws + WS_WGU) + (size_t)e * 512 * 1024, 1024, (q / 8) * 64, (q % 8) * 32, nullptr, 1.f, scr, lane); continue; } r -= I_EG;
        if (r < I_EG) { const int e = r / 128, q = r % 128; transpose_item<3>(P.w_eu + (size_t)e * 1024 * 256, 256, (bf16*)(ws + WS_WGU) + (size_t)e * 512 * 1024, 1024, (q / 8) * 64, (q % 8) * 32, nullptr, 1.f, scr, lane); continue; } r -= I_EG;
        { const int e = r / 128, q = r % 128; transpose_item<0>(P.w_ed + (size_t)e * 256 * 1024, 1024, (bf16*)(ws + WS_WDN) + (size_t)e * 1024 * 256, 256, (q / 32) * 64, (q % 32) * 32, nullptr, 1.f, scr, lane); }
    }
    { const int gt = gw * 64 + lane, NGT = NGW * 64; f32x2* rt = (f32x2*)(ws + WS_ROPE);
      for (int idx = gt; idx < SEQ * 32; idx += NGT) { const int pos = idx >> 5, i = idx & 31; float c, s; sincos_d((double)pos * INV_FREQ[i], c, s); rt[idx] = (f32x2){c, s}; } }
    { f32x4 g[4];
#pragma unroll
      for (int j = 0; j < 4; ++j) g[j] = *((const f32x4*)P.g_mix + lane + 64 * j);
      bf16* XN = (bf16*)(ws + WS_XN);
      for (int m = gw; m < M; m += NGW) {
          const f32x4* xr = (const f32x4*)(P.x + (size_t)m * DM) + lane; f32x4 v[4]; float s = 0.f;
#pragma unroll
          for (int j = 0; j < 4; ++j) { v[j] = xr[64 * j]; s += (v[j].x * v[j].x + v[j].y * v[j].y) + (v[j].z * v[j].z + v[j].w * v[j].w); }
          const float rstd = 1.0f / sqrtf(wave_sum(s) * (1.f / DM) + EPS);
          u32x2* o8 = (u32x2*)(XN + (size_t)m * DM) + lane;
#pragma unroll
          for (int j = 0; j < 4; ++j) { const f32x4 y = v[j] * rstd * g[j]; o8[64 * j] = (u32x2){cvtpk(y.x, y.y), cvtpk(y.z, y.w)}; }
      } }
}

__device__ __forceinline__ s16x4 vtr(const LAS unsigned char* p) { return __builtin_bit_cast(s16x4, __builtin_amdgcn_ds_read_tr16_b64_v4i16((LAS v4i16_t*)p)); }
#define VFRAG(lo, hi_) ((bf16x8){lo[0], lo[1], lo[2], lo[3], hi_[0], hi_[1], hi_[2], hi_[3]})
__device__ __forceinline__ bf16x8 packp(const f32x16& p, int b) { u32x4 w; w.x = cvtpk(p[b], p[b + 1]); w.y = cvtpk(p[b + 2], p[b + 3]); w.z = cvtpk(p[b + 4], p[b + 5]); w.w = cvtpk(p[b + 6], p[b + 7]); return __builtin_bit_cast(bf16x8, w); }

constexpr int DKV_BUF = 32768, DLK = 0, DLV = 16384;
__device__ __forceinline__ void diff_unit(LAS unsigned char* lds, int b, int h, int qt, const bf16* DQ, const bf16* DK, const bf16* DV, bf16* O, float lam) {
    const int tid = threadIdx.x, lane = tid & 63, r32 = lane & 31, hi = lane >> 5; const int wid = __builtin_amdgcn_readfirstlane(tid >> 6);
    const int c = wid >> 2, wq = wid & 3;
    const size_t rowbase = (size_t)b * SEQ; const int q0 = qt * 128, NT = (q0 + 128) / 64;
    const int qmin = q0 + wq * 32, q = qmin + r32;
    const bf16* ksrc = DK + (rowbase + lane) * 512 + h * 128 + wid * 8;
    const int vp0 = 2 * wid, vp1 = 2 * wid + 1;
    const bf16* vsrc0 = DV + (rowbase + 16 * (vp0 & 3) + (lane >> 2)) * 512 + h * 128 + (vp0 >> 2) * 32 + (lane & 3) * 8;
    const bf16* vsrc1 = DV + (rowbase + 16 * (vp1 & 3) + (lane >> 2)) * 512 + h * 128 + (vp1 >> 2) * 32 + (lane & 3) * 8;
    const int kd0 = DLK + wid * 1024 + lane * 16, kd1 = DLK + (8 + wid) * 1024 + lane * 16, vd0 = DLV + vp0 * 1024 + lane * 16, vd1 = DLV + vp1 * 1024 + lane * 16;
    bf16x8 qr[4];
#pragma unroll
    for (int d0 = 0; d0 < 4; ++d0) qr[d0] = *(const bf16x8*)(DQ + (rowbase + q) * 512 + h * 128 + c * 64 + d0 * 16 + hi * 8);
    f32x16 oT[4];
#pragma unroll
    for (int i = 0; i < 4; ++i) oT[i] = (f32x16){};
    float mrun = -INFINITY, lrun = 0.f;
    u32x4 st0, st1, st2, st3;
    st0 = *(const u32x4*)ksrc; st1 = *(const u32x4*)(ksrc + 64); st2 = *(const u32x4*)vsrc0; st3 = *(const u32x4*)vsrc1;
    *(LAS u32x4*)(lds + kd0) = st0; *(LAS u32x4*)(lds + kd1) = st1; *(LAS u32x4*)(lds + vd0) = st2; *(LAS u32x4*)(lds + vd1) = st3;
    __syncthreads();
    const int kfo = (c * 8 + hi) * 1024 + r32 * 16;
    const int vfo = DLV + ((lane >> 4) & 1) * 32 + (lane & 3) * 8 + (4 * hi + ((lane & 15) >> 2)) * 64;
    for (int t = 0; t < NT; ++t) {
        const int cur = (t & 1) * DKV_BUF, nxb = DKV_BUF - cur;
        const bool pf = (t + 1 < NT);
        if (pf) { const size_t o = (size_t)(t + 1) * 64 * 512; st0 = *(const u32x4*)(ksrc + o); st1 = *(const u32x4*)(ksrc + o + 64); st2 = *(const u32x4*)(vsrc0 + o); st3 = *(const u32x4*)(vsrc1 + o); }
        if (64 * t <= qmin + 31) {
            f32x16 p0 = (f32x16){}, p1 = (f32x16){};
            const LAS unsigned char* kb = lds + cur + DLK + kfo;
#pragma unroll
            for (int d0 = 0; d0 < 4; ++d0) { const bf16x8 k0 = *(const LAS bf16x8*)(kb + d0 * 2048), k1 = *(const LAS bf16x8*)(kb + d0 * 2048 + 512);
                p0 = MFMA32(k0, qr[d0], p0); p1 = MFMA32(k1, qr[d0], p1); }
            if (64 * t + 63 > qmin) {
                const int kb0 = 64 * t + 4 * hi;
#pragma unroll
                for (int i = 0; i < 16; ++i) { const int kv = kb0 + (i & 3) + 8 * (i >> 2); if (kv > q) p0[i] = -INFINITY; if (kv + 32 > q) p1[i] = -INFINITY; }
            }
            float rm = fmaxf(p0[0], p1[0]);
#pragma unroll
            for (int i = 1; i < 16; ++i) rm = fmaxf(rm, fmaxf(p0[i], p1[i]));
            rm = fmaxf(rm, __shfl_xor(rm, 32));
            const float mn = fmaxf(mrun, rm), alpha = ex2(mrun - mn); mrun = mn;
            float ls = 0.f;
#pragma unroll
            for (int i = 0; i < 16; ++i) { p0[i] = ex2(p0[i] - mn); p1[i] = ex2(p1[i] - mn); ls += p0[i] + p1[i]; }
            lrun = lrun * alpha + ls;
#pragma unroll
            for (int d = 0; d < 4; ++d)
#pragma unroll
                for (int i = 0; i < 16; ++i) oT[d][i] *= alpha;
            const bf16x8 pf0 = packp(p0, 0), pf1 = packp(p0, 8), pf2 = packp(p1, 0), pf3 = packp(p1, 8);
            const LAS unsigned char* vb = lds + cur + vfo;
#pragma unroll
            for (int d = 0; d < 4; ++d) {
                s16x4 l0 = vtr(vb + (d * 4 + 0) * 1024), h0 = vtr(vb + (d * 4 + 0) * 1024 + 512);
                s16x4 l1 = vtr(vb + (d * 4 + 1) * 1024), h1 = vtr(vb + (d * 4 + 1) * 1024 + 512);
                s16x4 l2 = vtr(vb + (d * 4 + 2) * 1024), h2 = vtr(vb + (d * 4 + 2) * 1024 + 512);
                s16x4 l3 = vtr(vb + (d * 4 + 3) * 1024), h3 = vtr(vb + (d * 4 + 3) * 1024 + 512);
                oT[d] = MFMA32(VFRAG(l0, h0), pf0, oT[d]); oT[d] = MFMA32(VFRAG(l1, h1), pf1, oT[d]);
                oT[d] = MFMA32(VFRAG(l2, h2), pf2, oT[d]); oT[d] = MFMA32(VFRAG(l3, h3), pf3, oT[d]);
            }
        }
        if (pf) { *(LAS u32x4*)(lds + nxb + kd0) = st0; *(LAS u32x4*)(lds + nxb + kd1) = st1; *(LAS u32x4*)(lds + nxb + vd0) = st2; *(LAS u32x4*)(lds + nxb + vd1) = st3; }
        __syncthreads();
    }
    const float lt = lrun + __shfl_xor(lrun, 32); const float inv = 1.0f / lt;
    LAS f32x4* xch = (LAS f32x4*)lds + (size_t)wq * 1024 + lane;
    if (c == 1) {
        const float sc = inv * lam;
#pragma unroll
        for (int d = 0; d < 4; ++d)
#pragma unroll
            for (int g = 0; g < 4; ++g) xch[(d * 4 + g) * 64] = (f32x4){oT[d][4 * g] * sc, oT[d][4 * g + 1] * sc, oT[d][4 * g + 2] * sc, oT[d][4 * g + 3] * sc};
    }
    __syncthreads();
    if (c == 0) {
        float ss = 0.f;
#pragma unroll
        for (int d = 0; d < 4; ++d)
#pragma unroll
            for (int g = 0; g < 4; ++g) { const f32x4 o2 = xch[(d * 4 + g) * 64];
#pragma unroll
                for (int j = 0; j < 4; ++j) { const float v = oT[d][4 * g + j] * inv - o2[j]; oT[d][4 * g + j] = v; ss += v * v; } }
        ss += __shfl_xor(ss, 32);
        const float rstd = 1.0f / sqrtf(ss * (1.0f / 128.0f) + EPS);
        bf16* orow = O + (rowbase + q) * 512 + h * 128 + 4 * hi;
#pragma unroll
        for (int d = 0; d < 4; ++d)
#pragma unroll
            for (int g = 0; g < 4; ++g) *(u32x2*)(orow + d * 32 + g * 8) = (u32x2){cvtpk(oT[d][4 * g] * rstd, oT[d][4 * g + 1] * rstd), cvtpk(oT[d][4 * g + 2] * rstd, oT[d][4 * g + 3] * rstd)};
    }
    __syncthreads();
}

__device__ __forceinline__ void sb_block(f32x16& z, int kbase, int q, int hi, float& carry) {
    float s[16], T[4], To[4], P[4];
    bool vis[16];
#pragma unroll
    for (int i = 0; i < 16; ++i) { const int key = kbase + (i & 3) + 8 * (i >> 2); vis[i] = key < q; const float e = ex2(fminf(z[i], 126.f)); const float l = lg2(1.0f + e); s[i] = vis[i] ? l : 0.f; }
#pragma unroll
    for (int g = 0; g < 4; ++g) { s[4 * g + 2] += s[4 * g + 3]; s[4 * g + 1] += s[4 * g + 2]; s[4 * g] += s[4 * g + 1]; T[g] = s[4 * g]; }
#pragma unroll
    for (int g = 0; g < 4; ++g) { To[g] = __shfl_xor(T[g], 32); P[g] = T[g] + To[g]; }
    const float sp2 = P[3], sp1 = P[3] + P[2], sp0 = sp1 + P[1], tot = sp0 + P[0];
    const float suf[4] = {sp0, sp1, sp2, 0.f};
#pragma unroll
    for (int g = 0; g < 4; ++g) { const float off = carry + suf[g] + (hi == 0 ? To[g] : 0.f);
#pragma unroll
        for (int j = 0; j < 4; ++j) { const float a = ex2(z[4 * g + j] - (off + s[4 * g + j])); z[4 * g + j] = vis[4 * g + j] ? a : 0.f; } }
    carry += tot;
}
constexpr int SKV_BUF = 16384, SLK = 0, SLV = 8192, SFLAG = 32768;
__device__ __forceinline__ void sb_unit(LAS unsigned char* lds, int b, int h, int qt, const bf16* Q, const bf16* Kg, const bf16* Vg, bf16* O) {
    const int tid = threadIdx.x, lane = tid & 63, r32 = lane & 31, hi = lane >> 5; const int wid = __builtin_amdgcn_readfirstlane(tid >> 6);
    const size_t rowbase = (size_t)b * SEQ; const int q0 = qt * 256, qmin = q0 + wid * 32, q = qmin + r32;
    const int ttop = (q0 + 255) >> 6, ttw = (qmin + 31) >> 6;
    const bf16* ksrc = Kg + (rowbase + lane) * 512 + h * 64 + wid * 8;
    const bf16* vsrc = Vg + (rowbase + 16 * (wid & 3) + (lane >> 2)) * 512 + h * 64 + (wid >> 2) * 32 + (lane & 3) * 8;
    const int kd = SLK + wid * 1024 + lane * 16, vd = SLV + wid * 1024 + lane * 16;
    bf16x8 qr[4];
#pragma unroll
    for (int d0 = 0; d0 < 4; ++d0) qr[d0] = *(const bf16x8*)(Q + (rowbase + q) * 512 + h * 64 + d0 * 16 + hi * 8);
    f32x16 oT[2]; oT[0] = (f32x16){}; oT[1] = (f32x16){};
    float carry = 0.f; bool fin = false;
    volatile LAS unsigned* flags = (volatile LAS unsigned*)(lds + SFLAG);
    u32x4 st0, st1;
    { const size_t o = (size_t)ttop * 64 * 512; st0 = *(const u32x4*)(ksrc + o); st1 = *(const u32x4*)(vsrc + o); }
    *(LAS u32x4*)(lds + kd) = st0; *(LAS u32x4*)(lds + vd) = st1;
    __syncthreads();
    const int kfo = hi * 1024 + r32 * 16;
    const int vfo = SLV + ((lane >> 4) & 1) * 32 + (lane & 3) * 8 + (4 * hi + ((lane & 15) >> 2)) * 64;
    int par = 0;
    for (int t = ttop; t >= 0; --t) {
        const int cur = par * SKV_BUF, nxb = SKV_BUF - cur;
        const bool pf = (t > 0);
        if (pf) { const size_t o = (size_t)(t - 1) * 64 * 512; st0 = *(const u32x4*)(ksrc + o); st1 = *(const u32x4*)(vsrc + o); }
        if (t <= ttw && !fin) {
            f32x16 p0 = (f32x16){}, p1 = (f32x16){};
            const LAS unsigned char* kb = lds + cur + SLK + kfo;
#pragma unroll
            for (int d0 = 0; d0 < 4; ++d0) { const bf16x8 k0 = *(const LAS bf16x8*)(kb + d0 * 2048), k1 = *(const LAS bf16x8*)(kb + d0 * 2048 + 512);
                p0 = MFMA32(k0, qr[d0], p0); p1 = MFMA32(k1, qr[d0], p1); }
            sb_block(p1, 64 * t + 32 + 4 * hi, q, hi, carry);
            sb_block(p0, 64 * t + 4 * hi, q, hi, carry);
            const bf16x8 pf0 = packp(p0, 0), pf1 = packp(p0, 8), pf2 = packp(p1, 0), pf3 = packp(p1, 8);
            const LAS unsigned char* vb = lds + cur + vfo;
#pragma unroll
            for (int d = 0; d < 2; ++d) {
                s16x4 l0 = vtr(vb + (d * 4 + 0) * 1024), h0 = vtr(vb + (d * 4 + 0) * 1024 + 512);
                s16x4 l1 = vtr(vb + (d * 4 + 1) * 1024), h1 = vtr(vb + (d * 4 + 1) * 1024 + 512);
                s16x4 l2 = vtr(vb + (d * 4 + 2) * 1024), h2 = vtr(vb + (d * 4 + 2) * 1024 + 512);
                s16x4 l3 = vtr(vb + (d * 4 + 3) * 1024), h3 = vtr(vb + (d * 4 + 3) * 1024 + 512);
                oT[d] = MFMA32(VFRAG(l0, h0), pf0, oT[d]); oT[d] = MFMA32(VFRAG(l1, h1), pf1, oT[d]);
                oT[d] = MFMA32(VFRAG(l2, h2), pf2, oT[d]); oT[d] = MFMA32(VFRAG(l3, h3), pf3, oT[d]);
            }
            fin = __all(carry > SB_STOP);
        }
        if (pf) { *(LAS u32x4*)(lds + nxb + kd) = st0; *(LAS u32x4*)(lds + nxb + vd) = st1; }
        if (lane == 0) flags[par * 8 + wid] = fin ? 1u : 0u;
        __syncthreads();
        unsigned all = 1u;
#pragma unroll
        for (int w = 0; w < 8; ++w) all &= flags[par * 8 + w];
        par ^= 1;
        if (all) break;
    }
    bf16* orow = O + (rowbase + q) * 512 + h * 64 + 4 * hi;
#pragma unroll
    for (int d = 0; d < 2; ++d)
#pragma unroll
        for (int g = 0; g < 4; ++g) *(u32x2*)(orow + d * 32 + g * 8) = (u32x2){cvtpk(oT[d][4 * g], oT[d][4 * g + 1]), cvtpk(oT[d][4 * g + 2], oT[d][4 * g + 3])};
    __syncthreads();
}

constexpr int R_WT = 0, R_REC = 147456;
__device__ __forceinline__ void p5_router(const Ptrs& P, LAS unsigned char* lds, int vcu, int G, int wave, int lane) {
    const int tid = threadIdx.x;
    LAS float* WT = (LAS float*)(lds + R_WT);
    LAS int* rec_e = (LAS int*)(lds + R_REC); LAS float* rec_w = (LAS float*)(lds + R_REC + 1024); LAS int* rec_p = (LAS int*)(lds + R_REC + 2048);
    LAS int* lcnt = (LAS int*)(lds + R_REC + 3072); LAS int* lbase = (LAS int*)(lds + R_REC + 3072 + 128);
    for (int k = tid; k < 1024; k += NTHREADS) {
        const f32x4 g4 = *(const f32x4*)(P.w_rg + (size_t)k * 4);
        WT[0 * 1024 + k] = g4.x; WT[1 * 1024 + k] = g4.y; WT[2 * 1024 + k] = g4.z; WT[3 * 1024 + k] = g4.w;
#pragma unroll
        for (int j = 0; j < 8; ++j) { const f32x4 e4 = *(const f32x4*)(P.w_re + (size_t)k * 32 + 4 * j);
            WT[(4 + 4 * j) * 1024 + k] = e4.x; WT[(5 + 4 * j) * 1024 + k] = e4.y; WT[(6 + 4 * j) * 1024 + k] = e4.z; WT[(7 + 4 * j) * 1024 + k] = e4.w; }
    }
    if (tid < 32) lcnt[tid] = 0;
    __syncthreads();
    f32x4 g[4];
#pragma unroll
    for (int j = 0; j < 4; ++j) g[j] = *((const f32x4*)P.g_ffn + lane + 64 * j);
    float bias[36];
#pragma unroll
    for (int e = 0; e < 4; ++e) bias[e] = P.b_rg[e];
#pragma unroll
    for (int e = 0; e < 32; ++e) bias[4 + e] = P.b_re[e];
    bf16* H2 = (bf16*)(P.ws + WS_XN);
    int* gcnt = (int*)(P.ws + WS_CTL) + CW_CNT; int* ltok = (int*)(P.ws + WS_LTOK); float* lw = (float*)(P.ws + WS_LW);
    for (int ch = vcu; ch < M / 128; ch += G) {
        for (int rr = 0; rr < 16; ++rr) {
            const int lrow = wave * 16 + rr, row = ch * 128 + lrow;
            const f32x4* xr = (const f32x4*)(P.out + (size_t)row * DM) + lane; f32x4 v[4]; float s = 0.f;
#pragma unroll
            for (int j = 0; j < 4; ++j) { v[j] = xr[64 * j]; s += (v[j].x * v[j].x + v[j].y * v[j].y) + (v[j].z * v[j].z + v[j].w * v[j].w); }
            const float rstd = 1.0f / sqrtf(wave_sum(s) * (1.f / DM) + EPS);
            u32x2* o8 = (u32x2*)(H2 + (size_t)row * DM) + lane;
#pragma unroll
            for (int j = 0; j < 4; ++j) { v[j] = v[j] * rstd * g[j]; o8[64 * j] = (u32x2){cvtpk(v[j].x, v[j].y), cvtpk(v[j].z, v[j].w)}; }
            float lg[36];
#pragma unroll
            for (int e = 0; e < 36; ++e) { float a = 0.f;
#pragma unroll
                for (int j = 0; j < 4; ++j) { const f32x4 w = *((const LAS f32x4*)(WT + e * 1024) + lane + 64 * j); a += (v[j].x * w.x + v[j].y * w.y) + (v[j].z * w.z + v[j].w * w.w); }
                lg[e] = wave_sum(a) + bias[e]; }
            int gi = 0; float gm = lg[0];
#pragma unroll
            for (int e = 1; e < 4; ++e) if (lg[e] > gm) { gm = lg[e]; gi = e; }
            float gs = 0.f;
#pragma unroll
            for (int e = 0; e < 4; ++e) gs += __expf(lg[e] - gm);
            const float pg = 1.0f / gs;
            float el[8];
#pragma unroll
            for (int j = 0; j < 8; ++j) el[j] = gi == 0 ? lg[4 + j] : gi == 1 ? lg[12 + j] : gi == 2 ? lg[20 + j] : lg[28 + j];
            int i1 = 0; float m1 = el[0];
#pragma unroll
            for (int j = 1; j < 8; ++j) if (el[j] > m1) { m1 = el[j]; i1 = j; }
            int i2 = -1; float m2 = -INFINITY;
#pragma unroll
            for (int j = 0; j < 8; ++j) if (j != i1 && el[j] > m2) { m2 = el[j]; i2 = j; }
            const float r = __expf(m2 - m1), w1 = pg / (1.0f + r), w2 = pg * r / (1.0f + r);
            if (lane == 0) {
                const int e1 = gi * 8 + i1, e2 = gi * 8 + i2;
                rec_e[lrow * 2] = e1; rec_e[lrow * 2 + 1] = e2; rec_w[lrow * 2] = w1; rec_w[lrow * 2 + 1] = w2;
                rec_p[lrow * 2] = __hip_atomic_fetch_add(&lcnt[e1], 1, __ATOMIC_RELAXED, __HIP_MEMORY_SCOPE_WORKGROUP); rec_p[lrow * 2 + 1] = __hip_atomic_fetch_add(&lcnt[e2], 1, __ATOMIC_RELAXED, __HIP_MEMORY_SCOPE_WORKGROUP);
            }
        }
        __syncthreads();
        if (tid < 32) { const int n = lcnt[tid]; lbase[tid] = n ? atomicAdd(gcnt + 64 * tid, n) : 0; }
        __syncthreads();
        if (tid < 256) { const int e = rec_e[tid], pos = lbase[e] + rec_p[tid]; ltok[(size_t)e * LCAP + pos] = (ch * 128 + (tid >> 1)) * 2 + (tid & 1); lw[(size_t)e * LCAP + pos] = rec_w[tid]; }
        if (tid < 32) lcnt[tid] = 0;
        __syncthreads();
    }
}
__device__ __forceinline__ MoeTables moe_tables(const Ptrs& P, LAS unsigned char* lds) {
    LAS int* tstart = (LAS int*)(lds + SCHED_OFF); LAS int* cnt = (LAS int*)(lds + SCHED_OFF + 256);
    const int tid = threadIdx.x;
    if (tid < 32) cnt[tid] = (int)__hip_atomic_load((unsigned*)(P.ws + WS_CTL) + CW_CNT + 64 * tid, RLX_AGENT);
    __syncthreads();
    if (tid == 0) { int a = 0; for (int e = 0; e < NEXP; ++e) { tstart[e] = a; a += (cnt[e] + 255) >> 8; } tstart[NEXP] = a; }
    __syncthreads();
    MoeTables tb; tb.tstart = tstart; tb.cnt = cnt; return tb;
}
__device__ __forceinline__ void p8_final(const Ptrs& P, int vcu, int G, int wave, int lane) {
    const int gw = vcu * NWAVES + wave, NGW = G * NWAVES;
    f32x4 g[4];
#pragma unroll
    for (int j = 0; j < 4; ++j) g[j] = *((const f32x4*)P.g_fin + lane + 64 * j);
    const bf16* YA = (const bf16*)(P.ws + WS_YA);
    for (int m = gw; m < M; m += NGW) {
        f32x4* xr = (f32x4*)(P.out + (size_t)m * DM) + lane; const u32x2* y0 = (const u32x2*)(YA + (size_t)(2 * m) * DM) + lane; const u32x2* y1 = (const u32x2*)(YA + (size_t)(2 * m + 1) * DM) + lane;
        f32x4 v[4]; float s = 0.f;
#pragma unroll
        for (int j = 0; j < 4; ++j) { const f32x4 xv = xr[64 * j]; const u32x2 a = y0[64 * j], b2 = y1[64 * j];
            v[j].x = xv.x + bf_lo(a.x) + bf_lo(b2.x); v[j].y = xv.y + bf_hi(a.x) + bf_hi(b2.x); v[j].z = xv.z + bf_lo(a.y) + bf_lo(b2.y); v[j].w = xv.w + bf_hi(a.y) + bf_hi(b2.y);
            s += (v[j].x * v[j].x + v[j].y * v[j].y) + (v[j].z * v[j].z + v[j].w * v[j].w); }
        const float rstd = 1.0f / sqrtf(wave_sum(s) * (1.f / DM) + EPS);
#pragma unroll
        for (int j = 0; j < 4; ++j) xr[64 * j] = v[j] * rstd * g[j];
    }
}

struct Args { Ptrs p; int ph_lo, ph_hi; };
__global__ void __launch_bounds__(NTHREADS, 2) fwd_kernel(Args args) {
    extern __shared__ __attribute__((aligned(16))) unsigned char lds_raw[];
    LAS unsigned char* lds = (LAS unsigned char*)lds_raw;
    const Ptrs& P = args.p;
    const int tid = threadIdx.x, lane = tid & 63, wave = __builtin_amdgcn_readfirstlane(tid >> 6);
    const int G = gridDim.x, bx = blockIdx.x; const int vcu = (G % 8 == 0) ? (bx % 8) * (G / 8) + bx / 8 : bx;
    unsigned char* ws = P.ws;
    volatile LAS unsigned* MISC = (volatile LAS unsigned*)(lds + MISC_OFF);
    if (tid < 64) MISC[tid] = 0u;
    __syncthreads();
    XcdBarrier bar = xcd_barrier_post((unsigned*)(ws + WS_CTL) + CW_BAR, MISC);
    const int lo = args.ph_lo, hi_ = args.ph_hi;
#ifndef PH_MASK
#define PH_MASK 0x1ff
#endif
#define IN(k) (((PH_MASK >> (k)) & 1) && lo <= (k) && (k) < hi_)
#define SEAM(k) do { if (IN(k) && IN((k) + 1)) xcd_barrier(bar); } while (0)

    if (IN(0)) { p0_prologue(P, lds, vcu, G, wave, lane); }
    SEAM(0);
    if (IN(1)) {
        SchedDense S; S.T.init(M, IN_W, G, bx); S.A = (const char*)(ws + WS_XN); S.B = (const char*)(ws + WS_WIN); S.K = 1024;
        EpiInProj E{ws, (const f32x4*)(ws + WS_ROPE)};
        pg8::gemm_phase<EpiInProj, SchedDense, true>(lds, 1024, S, E);
    }
    SEAM(1);
    if (IN(2)) {
        LAS float* lamp = (LAS float*)(lds + 65536 + 4096);
        if (wave == 0) { const float a = wave_sum(P.lq1[lane] * P.lk1[lane]), b2 = wave_sum(P.lq2[lane] * P.lk2[lane]); if (lane == 0) lamp[0] = __expf(a) - __expf(b2) + 0.2f; }
        __syncthreads();
        const float lam = lamp[0];
        const bf16* DQ = (const bf16*)(ws + WS_SBQ + 3 * WS_SMALL_STRIDE); const bf16* DK = (const bf16*)(ws + WS_SBQ + 4 * WS_SMALL_STRIDE); const bf16* DV = (const bf16*)(ws + WS_SBQ + 5 * WS_SMALL_STRIDE);
        for (int i = 0; ; ++i) {
            int bh, qt;
            if (G == 256) { if (i >= 4) break; const int s = vcu & 7; bh = vcu >> 3; qt = (i == 0) ? s : (i == 1) ? 15 - s : (i == 2) ? 16 + s : 31 - s; }
            else { const int u = i * G + vcu; if (u >= 1024) break; bh = u >> 5; qt = u & 31; }
            diff_unit(lds, bh >> 2, bh & 3, qt, DQ, DK, DV, (bf16*)DQ, lam);
        }
        const bf16* SQ = (const bf16*)(ws + WS_SBQ); const bf16* SK = (const bf16*)(ws + WS_SBQ + 1 * WS_SMALL_STRIDE); const bf16* SV = (const bf16*)(ws + WS_SBQ + 2 * WS_SMALL_STRIDE);
        for (int i = 0; ; ++i) {
            int bh, qt;
            if (G == 256) { if (i >= 4) break; const int s = vcu & 3; bh = vcu >> 2; qt = (i == 0) ? s : (i == 1) ? 7 - s : (i == 2) ? 8 + s : 15 - s; }
            else { const int u = i * G + vcu; if (u >= 1024) break; bh = u >> 4; qt = u & 15; }
            sb_unit(lds, bh >> 3, bh & 7, qt, SQ, SK, SV, (bf16*)SQ);
        }
    }
    SEAM(2);
    if (IN(3)) {
        SchedUp S; S.T.init(M, 1024, G, bx); S.OA = (const char*)(ws + WS_SBQ); S.OB = (const char*)(ws + WS_SBQ + 3 * WS_SMALL_STRIDE); S.WA = (const char*)(ws + WS_WUPA); S.WB = (const char*)(ws + WS_WUPB);
        EpiUp E{(const bf16*)(ws + WS_GA), (const bf16*)(ws + WS_GB), (bf16*)(ws + WS_XN)};
        pg8::gemm_phase<EpiUp, SchedUp, true>(lds, 512, S, E);
    }
    SEAM(3);
    if (IN(4)) {
        SchedDense S; S.T.init(M, 1024, G, bx); S.A = (const char*)(ws + WS_XN); S.B = (const char*)(ws + WS_WOUT); S.K = 1024;
        EpiOut E{P.x, P.out};
        pg8::gemm_phase<EpiOut, SchedDense, true>(lds, 1024, S, E);
    }
    SEAM(4);
    if (IN(5)) { p5_router(P, lds, vcu, G, wave, lane); }
    SEAM(5);
    if (IN(6)) {
        const MoeTables tb = moe_tables(P, lds);
        SchedMoe<2, true> S{tb, G, bx, (const char*)(ws + WS_XN), (const char*)(ws + WS_WGU), (const int*)(ws + WS_LTOK), 1024, (size_t)512 * 1024 * 2};
        EpiMoeGU E{(bf16*)(ws + WS_HID)};
        pg8::gemm_phase<EpiMoeGU, SchedMoe<2, true>, true>(lds, 1024, S, E);
    }
    SEAM(6);
    if (IN(7)) {
        const MoeTables tb = moe_tables(P, lds);
        SchedMoe<4, false> S{tb, G, bx, (const char*)(ws + WS_HID), (const char*)(ws + WS_WDN), (const int*)(ws + WS_LTOK), 256, (size_t)1024 * 256 * 2};
        EpiMoeDown E{(bf16*)(ws + WS_YA), (const int*)(ws + WS_LTOK), (const float*)(ws + WS_LW)};
        pg8::gemm_phase<EpiMoeDown, SchedMoe<4, false>, true>(lds, 256, S, E);
    }
    SEAM(7);
    if (IN(8)) { p8_final(P, vcu, G, wave, lane); }
#undef IN
#undef SEAM
}

#ifndef MK_N_LAUNCHES
#define MK_N_LAUNCHES 1
#endif
extern "C" void kernel_launch(void* const* d_in, const int* in_sizes, int n_in, void* d_out, int out_size, void* d_ws, size_t ws_size, hipStream_t stream) {
    static int grid = 0;
    if (grid == 0) {
        if (n_in != 20 || in_sizes[0] != M * DM || out_size != M * DM || ws_size < WS_END) { fprintf(stderr, "kernel_launch: unexpected shapes (n_in %d, in0 %d, out %d, ws %zu)\n", n_in, n_in > 0 ? in_sizes[0] : -1, out_size, ws_size); grid = -1; return; }
        int dev = 0, cus = 0, per_cu = 0;
        if (hipGetDevice(&dev) != hipSuccess || hipDeviceGetAttribute(&cus, hipDeviceAttributeMultiprocessorCount, dev) != hipSuccess) { grid = -1; return; }
        if (hipFuncSetAttribute((const void*)fwd_kernel, hipFuncAttributeMaxDynamicSharedMemorySize, LDS_BYTES) != hipSuccess) { fprintf(stderr, "kernel_launch: hipFuncSetAttribute failed\n"); grid = -1; return; }
        if (hipOccupancyMaxActiveBlocksPerMultiprocessor(&per_cu, (const void*)fwd_kernel, NTHREADS, LDS_BYTES) != hipSuccess || per_cu < 1) fprintf(stderr, "kernel_launch: occupancy query reports %d\n", per_cu);
        (void)hipGetLastError();
        grid = cus;
    }
    if (grid < 0) return;
    (void)hipMemsetAsync((char*)d_ws + WS_CTL, 0, CTL_ZERO_BYTES, stream);
    Args a{};
    const float** pp = (const float**)&a.p;
    for (int i = 0; i < 20; ++i) pp[i] = (const float*)d_in[i];
    a.p.out = (float*)d_out; a.p.ws = (unsigned char*)d_ws;
#if MK_N_LAUNCHES == 1
    a.ph_lo = 0; a.ph_hi = 9;
    hipLaunchKernelGGL(fwd_kernel, dim3(grid), dim3(NTHREADS), LDS_BYTES, stream, a);
#else
    for (int ph = 0; ph < 9; ++ph) { a.ph_lo = ph; a.ph_hi = ph + 1; hipLaunchKernelGGL(fwd_kernel, dim3(grid), dim3(NTHREADS), LDS_BYTES, stream, a); }
#endif
}
```

```cpp
#include <hip/hip_runtime.h>
#include <cstdio>
#include <cstdint>

#define GAS __attribute__((address_space(1)))
#define LAS __attribute__((address_space(3)))
typedef unsigned short bf16;
typedef short bf16x8 __attribute__((ext_vector_type(8)));
typedef short s16x4 __attribute__((ext_vector_type(4)));
typedef short v4i16_t __attribute__((ext_vector_type(4)));
typedef float f32x2 __attribute__((ext_vector_type(2)));
typedef float f32x4 __attribute__((ext_vector_type(4)));
typedef float f32x16 __attribute__((ext_vector_type(16)));
typedef unsigned u32x2 __attribute__((ext_vector_type(2)));
typedef unsigned u32x4 __attribute__((ext_vector_type(4)));
typedef __bf16 bf16x2_t __attribute__((ext_vector_type(2)));
typedef GAS unsigned gu32;

constexpr int M = 32768, DM = 1024, SEQ = 4096, NBATCH = 8;
constexpr int IN_W = 5120;
constexpr int NEXP = 32, DEXP = 256;
constexpr int NWAVES = 8, NTHREADS = 512;
constexpr float EPS = 1e-6f;
constexpr float LOG2E = 1.4426950408889634f;
constexpr float C2 = 0.125f * 1.4426950408889634f;
constexpr float SB_STOP = 152.0f;

constexpr size_t MiB = 1u << 20;
constexpr size_t WS_CTL = 0, CTL_ZERO_BYTES = 128 * 1024;
constexpr size_t WS_WR = 512 * 1024;
constexpr size_t WS_ROPE = 1 * MiB;
constexpr size_t WS_WIN = 2 * MiB;
constexpr size_t WS_WUPA = 12 * MiB, WS_WUPB = 13 * MiB;
constexpr size_t WS_WOUT = 14 * MiB;
constexpr size_t WS_WGU = 16 * MiB;
constexpr size_t WS_WDN = 48 * MiB;
constexpr size_t WS_XN = 64 * MiB;
constexpr size_t WS_SBQ = 128 * MiB;
constexpr size_t WS_SMALL_STRIDE = 32 * MiB;
constexpr size_t WS_GA = 320 * MiB, WS_GB = 384 * MiB;
constexpr size_t WS_HID = 160 * MiB;
constexpr size_t WS_X1B = 224 * MiB;
constexpr size_t WS_LTOK = 288 * MiB, WS_LW = 292 * MiB, WS_LRS = 296 * MiB;
constexpr size_t WS_YA = 320 * MiB;
constexpr size_t WS_END = 448 * MiB;
constexpr int LCAP = 32768;

constexpr int CW_TMO = 0;
constexpr int CW_BAR = 4096;
constexpr int CW_CNT = 16384;

constexpr int LDS_BYTES = 163840;
constexpr int MISC_OFF = LDS_BYTES - 256;
constexpr int SCHED_OFF = 131072;

#define RLX_AGENT __ATOMIC_RELAXED, __HIP_MEMORY_SCOPE_AGENT
__device__ __forceinline__ unsigned cvtpk(float lo, float hi) { f32x2 v = {lo, hi}; bf16x2_t b = __builtin_convertvector(v, bf16x2_t); return __builtin_bit_cast(unsigned, b); }
__device__ __forceinline__ float bf_lo(unsigned w) { return __uint_as_float(w << 16); }
__device__ __forceinline__ float bf_hi(unsigned w) { return __uint_as_float(w & 0xffff0000u); }
__device__ __forceinline__ float wave_sum(float v) {
#pragma unroll
    for (int o = 1; o < 64; o <<= 1) v += __shfl_xor(v, o);
    return v;
}
__device__ __forceinline__ float ex2(float x) { return __builtin_amdgcn_exp2f(x); }
__device__ __forceinline__ float lg2(float x) { return __builtin_amdgcn_logf(x); }
__device__ __forceinline__ float sigmoidf_(float x) { return __builtin_amdgcn_rcpf(1.0f + ex2(-x * LOG2E)); }
__device__ __forceinline__ int crow(int r, int hi) { return (r & 3) + 8 * (r >> 2) + 4 * hi; }
#define MFMA32(a, b, c) __builtin_amdgcn_mfma_f32_32x32x16_bf16(a, b, c, 0, 0, 0)

#define XB_TMO      128
#define XB_XCNT(j)  (256  + 64 * (j))
#define XB_XSUB(j)  (1280 + 64 * (j))
#define XB_XGEN(j)  (2304 + 64 * (j))
#define XB_TOP      3328
#define XB_TOPGEN   3392
#define XCD_BAR_WORDS 3456
#define XB_SPIN_CAP (1u << 18)
__device__ __forceinline__ unsigned xb_ld(unsigned* p)              { return __hip_atomic_load(p, __ATOMIC_RELAXED, __HIP_MEMORY_SCOPE_AGENT); }
__device__ __forceinline__ unsigned xb_add(unsigned* p, unsigned v) { return __hip_atomic_fetch_add(p, v, __ATOMIC_RELAXED, __HIP_MEMORY_SCOPE_AGENT); }
__device__ __forceinline__ unsigned xb_xcc_id() { return (unsigned)__builtin_amdgcn_s_getreg((3 << 11) | 20) & 0xFu; }
#define XB_SPIN(cond, bar) do { unsigned _sp = 0; while (cond) { __builtin_amdgcn_s_sleep(1); \
    if ((++_sp & 255u) == 0u) { if (xb_ld(&(bar)[XB_TMO])) break; if (_sp > XB_SPIN_CAP) { atomicAdd(&(bar)[XB_TMO], 1u); break; } } } } while (0)
struct XcdBarrier { unsigned* bar; unsigned x; volatile LAS unsigned* st; };
__device__ __forceinline__ XcdBarrier xcd_barrier_post(unsigned* bar, volatile LAS unsigned* st) {
    XcdBarrier b; b.bar = bar; b.x = xb_xcc_id(); b.st = st;
    if (threadIdx.x == 0) (void)xb_add(&bar[XB_XCNT(b.x)], 1u);
    return b;
}
__device__ __forceinline__ void xcd_barrier_complete(unsigned* bar, unsigned x, unsigned& nloc, unsigned& nx) {
    const unsigned G = gridDim.x * gridDim.y * gridDim.z;
    unsigned sum, cnt, mine, sp = 0u;
    for (;;) {
        sum = 0u; cnt = 0u; mine = 0u;
#pragma unroll
        for (unsigned j = 0; j < 16; ++j) { const unsigned c = xb_ld(&bar[XB_XCNT(j)]); sum += c; cnt += (c > 0u) ? 1u : 0u; mine = (j == x) ? c : mine; }
        if (sum == G) break;
        __builtin_amdgcn_s_sleep(1);
        if ((++sp & 255u) == 0u) { if (xb_ld(&bar[XB_TMO])) break; if (sp > XB_SPIN_CAP) { atomicAdd(&bar[XB_TMO], 1u); break; } }
    }
    nloc = mine > 0u ? mine : 1u; nx = cnt > 0u ? cnt : 1u;
}
__device__ __forceinline__ void xcd_barrier(const XcdBarrier& b) {
    asm volatile("s_waitcnt vmcnt(0)" ::: "memory");
    __syncthreads();
    if (threadIdx.x == 0) {
        unsigned* bar = b.bar;
        __builtin_amdgcn_s_waitcnt(0);
        unsigned nloc = b.st[0], nx = b.st[1];
        if (nloc == 0u) { xcd_barrier_complete(bar, b.x, nloc, nx); b.st[0] = nloc; b.st[1] = nx; }
        const unsigned old = xb_add(&bar[XB_XSUB(b.x)], 1u);
        const unsigned gen = old / nloc;
        if (old + 1u == (gen + 1u) * nloc) {
            __builtin_amdgcn_fence(__ATOMIC_RELEASE, "agent");
            asm volatile("s_waitcnt vmcnt(0)" ::: "memory");
            const unsigned og = xb_add(&bar[XB_TOP], 1u);
            const unsigned tg = og / nx;
            if (og + 1u == (tg + 1u) * nx) xb_add(&bar[XB_TOPGEN], 1u);
            else XB_SPIN(xb_ld(&bar[XB_TOPGEN]) == tg, bar);
            __builtin_amdgcn_fence(__ATOMIC_ACQUIRE, "agent");
            xb_add(&bar[XB_XGEN(b.x)], 1u);
            asm volatile("s_waitcnt vmcnt(0)" ::: "memory");
        } else {
            XB_SPIN(xb_ld(&bar[XB_XGEN(b.x)]) == gen, bar);
            __builtin_amdgcn_fence(__ATOMIC_ACQUIRE, "agent");
            asm volatile("s_waitcnt vmcnt(0)" ::: "memory");
        }
    }
    __syncthreads();
}

namespace pg8 {
constexpr int BM = 256, BK = 64, HALF = 128, HTB = HALF * BK * 2, STAGE_BYTES = 8 * HTB, NXCD = 8, WGM = 8;
__host__ __device__ __forceinline__ int lds_byte(int r, int c) { const int st = (r >> 4) * 2 + (c >> 5), rr = r & 15, cc = c & 31, ob = rr * 64 + cc * 2; return st * 1024 + (ob ^ (((ob >> 9) & 1) << 5)); }
__host__ __device__ __forceinline__ void stage_rc(int b, int& R, int& C) { const int st = b / 1024, sb = b % 1024, swz = sb ^ (((sb >> 9) & 1) << 5); R = (st >> 1) * 16 + swz / 64; C = (st & 1) * 32 + (swz % 64) / 2; }
__host__ __device__ __forceinline__ int perm32(int rho) { const int n = rho >> 4, i = rho & 15; return 8 * (i >> 2) + 4 * n + (i & 3); }

struct Unit { int pm, pn, e, t, cnt, slot0; };

struct TileOrder {
    int nM, nN, nwg, G, c;
    __device__ void init(int M_, int N_, int G_, int c_) { nM = M_ / BM; nN = N_ / BM; nwg = nM * nN; G = G_; c = c_; }
    __device__ bool tile(int i, int& pm, int& pn) const {
        const long L = (long)i * G + c; if (L >= nwg) return false;
        int wgid = (int)L; { const int q = nwg / NXCD, r = nwg % NXCD, xcd = wgid % NXCD, off = wgid / NXCD; wgid = (xcd < r ? xcd * (q + 1) : r * (q + 1) + (xcd - r) * q) + off; }
        const int nig = WGM * nN, gid = wgid / nig, fm = gid * WGM, gsz = (nM - fm) < WGM ? (nM - fm) : WGM;
        pm = fm + ((wgid % nig) % gsz); pn = (wgid % nig) / gsz; return true;
    }
};

template <class Epi, class Sched, bool ALIGN_EPI>
__device__ __forceinline__ void gemm_phase(LAS unsigned char* lds, const int K, const Sched& S, const Epi& E) {
    const int tid = threadIdx.x, wid = __builtin_amdgcn_readfirstlane(tid >> 6), lane = tid & 63, wr = wid >> 2, wc = wid & 3, fr = lane & 15, fq = lane >> 4;
    const int nt = K / BK;
    int Rr[2], Cc[2]; unsigned voffB[2];
#pragma unroll
    for (int i = 0; i < 2; ++i) { int R, C; stage_rc(tid * 16 + i * 8192, R, C); Rr[i] = R; Cc[i] = C; const int Rb = Epi::PERM ? ((R & ~31) + perm32(R & 31)) : R; voffB[i] = (unsigned)(Rb * K + C) * 2u; }
    const size_t kstep = (size_t)(BK * 2);
    const size_t hstep = (size_t)HALF * K * 2;
    const unsigned ldsw = (unsigned)wid * 1024u;
    const int aoff = lds_byte(wr * 64 + fr, fq * 8), boff = lds_byte(wc * 32 + fr, fq * 8);
#define PG8_SA(b, h) (((b) * 2 + (h)) * HTB)
#define PG8_SB(b, h) ((4 + (b) * 2 + (h)) * HTB)
#define PG8_STAGE2(bufoff, gbase, v0, v1) do { \
        __builtin_amdgcn_global_load_lds((const unsigned*)((const char*)(gbase) + (v0)), (LAS unsigned*)(lds + (bufoff) + ldsw), 16, 0, 0); \
        __builtin_amdgcn_global_load_lds((const unsigned*)((const char*)(gbase) + (v1)), (LAS unsigned*)(lds + (bufoff) + ldsw + 8192), 16, 0, 0); } while (0)
#define PG8_STAGEB(bufoff, gbase) PG8_STAGE2(bufoff, gbase, voffB[0], voffB[1])
#define PG8_LDA(dst, b, h) do { _Pragma("unroll") for (int m = 0; m < 4; ++m) _Pragma("unroll") for (int k = 0; k < 2; ++k) dst[m][k] = *(const LAS bf16x8*)(lds + PG8_SA(b, h) + aoff + m * 2048 + k * 1024); } while (0)
#define PG8_LDB(dst, b, h) do { _Pragma("unroll") for (int n = 0; n < 2; ++n) _Pragma("unroll") for (int k = 0; k < 2; ++k) dst[n][k] = *(const LAS bf16x8*)(lds + PG8_SB(b, h) + boff + n * 2048 + k * 1024); } while (0)
#define PG8_MMA(ai, bj, At, Bt) do { __builtin_amdgcn_s_setprio(1); _Pragma("unroll") for (int m = 0; m < 4; ++m) _Pragma("unroll") for (int n = 0; n < 2; ++n) _Pragma("unroll") for (int k = 0; k < 2; ++k) \
        acc[ai][bj][m][n] = __builtin_amdgcn_mfma_f32_16x16x32_bf16(Bt[n][k], At[m][k], acc[ai][bj][m][n], 0, 0, 0); __builtin_amdgcn_s_setprio(0); } while (0)
#define PG8_WAIT_V(n) asm volatile("s_waitcnt vmcnt(" #n ")" ::: "memory")
#define PG8_WAIT_L(n) asm volatile("s_waitcnt lgkmcnt(" #n ")" ::: "memory")
#define PG8_BAR __builtin_amdgcn_s_barrier()
#define PG8_SCHED __builtin_amdgcn_sched_barrier(0)
    Unit cur, nxt; int ui = 0;
    if (!S.next(0, cur)) return;
    f32x4 acc[2][2][4][2];
#pragma unroll
    for (int a = 0; a < 2; ++a)
#pragma unroll
        for (int b = 0; b < 2; ++b)
#pragma unroll
            for (int m = 0; m < 4; ++m)
#pragma unroll
                for (int n = 0; n < 2; ++n) acc[a][b][m][n] = (f32x4){0.f, 0.f, 0.f, 0.f};
    bf16x8 At[4][2], B0[2][2], B1[2][2];
    const char* cA = S.a_ptr(cur); const char* cB = S.b_ptr(cur);
    unsigned vA00 = S.a_off(cur, Rr[0]) + (unsigned)Cc[0] * 2u, vA01 = S.a_off(cur, Rr[1]) + (unsigned)Cc[1] * 2u;
    unsigned vA10 = S.a_off(cur, HALF + Rr[0]) + (unsigned)Cc[0] * 2u, vA11 = S.a_off(cur, HALF + Rr[1]) + (unsigned)Cc[1] * 2u;
    PG8_STAGEB(PG8_SB(0, 0), cB); PG8_STAGEB(PG8_SB(0, 1), cB + hstep); PG8_STAGE2(PG8_SA(0, 0), cA, vA00, vA01); PG8_STAGE2(PG8_SA(0, 1), cA, vA10, vA11);
    if (wr == 1) PG8_BAR;
    PG8_WAIT_V(2); PG8_BAR;
    PG8_STAGEB(PG8_SB(1, 0), cB + kstep); PG8_STAGE2(PG8_SA(1, 0), cA + kstep, vA00, vA01); PG8_STAGEB(PG8_SB(1, 1), cB + hstep + kstep);
    PG8_WAIT_V(6); PG8_BAR;
    for (;;) {
        const bool has_next = S.next(ui + 1, nxt);
        const char* nA = has_next ? S.a_ptr(nxt) : cA; const char* nB = has_next ? S.b_ptr(nxt) : cB;
        unsigned nA00 = vA00, nA01 = vA01, nA10 = vA10, nA11 = vA11;
        if (has_next) { nA00 = S.a_off(nxt, Rr[0]) + (unsigned)Cc[0] * 2u; nA01 = S.a_off(nxt, Rr[1]) + (unsigned)Cc[1] * 2u;
                        nA10 = S.a_off(nxt, HALF + Rr[0]) + (unsigned)Cc[0] * 2u; nA11 = S.a_off(nxt, HALF + Rr[1]) + (unsigned)Cc[1] * 2u; }
        for (int t = 0; t < nt; t += 2) {
            const bool last = (t == nt - 2);
            const char* a1 = cA + (size_t)(t + 1) * kstep;
            const char* a2 = last ? nA : cA + (size_t)(t + 2) * kstep; const char* b2 = last ? nB : cB + (size_t)(t + 2) * kstep;
            const char* a3 = a2 + kstep; const char* b3 = b2 + kstep;
            const unsigned w00 = last ? nA00 : vA00, w01 = last ? nA01 : vA01, w10 = last ? nA10 : vA10, w11 = last ? nA11 : vA11;
            PG8_LDB(B0, 0, 0); PG8_LDB(B1, 0, 1); PG8_SCHED; PG8_LDA(At, 0, 0); PG8_STAGE2(PG8_SA(1, 1), a1, vA10, vA11);
            PG8_WAIT_V(8); PG8_WAIT_L(0); PG8_BAR; PG8_MMA(0, 0, At, B0); PG8_MMA(0, 1, At, B1); PG8_BAR; PG8_SCHED;
            PG8_LDA(At, 0, 1); PG8_STAGEB(PG8_SB(0, 0), b2); PG8_STAGEB(PG8_SB(0, 1), b2 + hstep); PG8_STAGE2(PG8_SA(0, 0), a2, w00, w01);
            PG8_WAIT_V(8); PG8_WAIT_L(0); PG8_BAR; PG8_MMA(1, 0, At, B0); PG8_MMA(1, 1, At, B1); PG8_BAR; PG8_SCHED;
            PG8_LDB(B0, 1, 0); PG8_LDB(B1, 1, 1); PG8_SCHED; PG8_LDA(At, 1, 0); PG8_STAGE2(PG8_SA(0, 1), a2, w10, w11);
            PG8_WAIT_V(8); PG8_WAIT_L(0); PG8_BAR; PG8_MMA(0, 0, At, B0); PG8_MMA(0, 1, At, B1); PG8_BAR; PG8_SCHED;
            PG8_LDA(At, 1, 1); PG8_STAGEB(PG8_SB(1, 0), b3); PG8_STAGEB(PG8_SB(1, 1), b3 + hstep); PG8_STAGE2(PG8_SA(1, 0), a3, w00, w01);
            PG8_WAIT_V(8); PG8_WAIT_L(0); PG8_BAR; PG8_MMA(1, 0, At, B0); PG8_MMA(1, 1, At, B1); PG8_BAR; PG8_SCHED;
        }
        if constexpr (ALIGN_EPI) { if (wr == 0) PG8_BAR; }
        const bool zero = E(acc, cur, wr, wc, fr, fq);
        if (!has_next) break;
        if (zero) {
#pragma unroll
        for (int a = 0; a < 2; ++a)
#pragma unroll
            for (int b = 0; b < 2; ++b)
#pragma unroll
                for (int m = 0; m < 4; ++m)
#pragma unroll
                    for (int n = 0; n < 2; ++n) acc[a][b][m][n] = (f32x4){0.f, 0.f, 0.f, 0.f};
        }
        cur = nxt; cA = nA; cB = nB; ++ui; vA00 = nA00; vA01 = nA01; vA10 = nA10; vA11 = nA11;
        if constexpr (ALIGN_EPI) { if (wr == 1) PG8_BAR; }
    }
    PG8_WAIT_V(0);
    if constexpr (!ALIGN_EPI) { if (wr == 0) PG8_BAR; }
    PG8_BAR;
#undef PG8_SA
#undef PG8_SB
#undef PG8_STAGE2
#undef PG8_STAGEB
#undef PG8_LDA
#undef PG8_LDB
#undef PG8_MMA
#undef PG8_WAIT_V
#undef PG8_WAIT_L
#undef PG8_BAR
#undef PG8_SCHED
}
}
using pg8::Unit;

struct SchedDense {
    pg8::TileOrder T; const char* A; const char* B; int K;
    __device__ __forceinline__ bool next(int i, Unit& u) const { u.e = 0; u.t = 0; u.cnt = 0; u.slot0 = 0; return T.tile(i, u.pm, u.pn); }
    __device__ __forceinline__ const char* a_ptr(const Unit& u) const { return A + (size_t)u.pm * 256 * K * 2; }
    __device__ __forceinline__ const char* b_ptr(const Unit& u) const { return B + (size_t)u.pn * 256 * K * 2; }
    __device__ __forceinline__ unsigned a_off(const Unit&, int row) const { return (unsigned)(row * K) * 2u; }
};
struct EpiInProj {
    static constexpr bool PERM = true;
    unsigned char* ws; const f32x4* rope;
    __device__ __forceinline__ bool operator()(const f32x4 (&acc)[2][2][4][2], const Unit& u, int wr, int wc, int fr, int fq) const {
        const int pn = u.pn; bf16* base; int ld, colt;
        if (pn < 12) { base = (bf16*)(ws + WS_SBQ + (size_t)(pn >> 1) * WS_SMALL_STRIDE); ld = 512; colt = (pn & 1) * 256; }
        else { base = (bf16*)(ws + WS_GA + (size_t)((pn - 12) >> 2) * (WS_GB - WS_GA)); ld = 1024; colt = ((pn - 12) & 3) * 256; }
        const float sc = (pn < 2 || pn == 6 || pn == 7) ? C2 : 1.0f;
        const bool rp = (pn >= 6 && pn < 10);
        const int row0 = u.pm * 256 + wr * 64 + fr, col0 = colt + wc * 32 + 8 * fq;
#pragma unroll
        for (int ai = 0; ai < 2; ++ai)
#pragma unroll
            for (int m = 0; m < 4; ++m) {
                const int row = row0 + ai * 128 + m * 16; bf16* rowp = base + (size_t)row * ld + col0;
#pragma unroll
                for (int bj = 0; bj < 2; ++bj) {
                    f32x4 v0 = acc[ai][bj][m][0], v1 = acc[ai][bj][m][1];
                    if (rp) {
                        const int i0 = ((col0 + bj * 128) & 63) >> 1;
                        const f32x4* rt = rope + (size_t)(row & (SEQ - 1)) * 16 + (i0 >> 1);
                        const f32x4 cs0 = rt[0], cs1 = rt[1];
                        f32x4 w0, w1;
                        w0[0] = v0[0] * cs0[0] - v0[1] * cs0[1]; w0[1] = v0[1] * cs0[0] + v0[0] * cs0[1];
                        w0[2] = v0[2] * cs0[2] - v0[3] * cs0[3]; w0[3] = v0[3] * cs0[2] + v0[2] * cs0[3];
                        w1[0] = v1[0] * cs1[0] - v1[1] * cs1[1]; w1[1] = v1[1] * cs1[0] + v1[0] * cs1[1];
                        w1[2] = v1[2] * cs1[2] - v1[3] * cs1[3]; w1[3] = v1[3] * cs1[2] + v1[2] * cs1[3];
                        v0 = w0; v1 = w1;
                    }
                    v0 = v0 * sc; v1 = v1 * sc;
                    u32x4 w; w.x = cvtpk(v0[0], v0[1]); w.y = cvtpk(v0[2], v0[3]); w.z = cvtpk(v1[0], v1[1]); w.w = cvtpk(v1[2], v1[3]);
                    *(u32x4*)(rowp + bj * 128) = w;
                }
            }
        return true;
    }
};

struct SchedUp {
    pg8::TileOrder T; const char* OA; const char* OB; const char* WA; const char* WB;
    __device__ __forceinline__ bool next(int i, Unit& u) const { u.e = i & 1; u.t = 0; u.cnt = 0; u.slot0 = 0; return T.tile(i >> 1, u.pm, u.pn); }
    __device__ __forceinline__ const char* a_ptr(const Unit& u) const { return (u.e ? OB : OA) + (size_t)u.pm * 256 * 512 * 2; }
    __device__ __forceinline__ const char* b_ptr(const Unit& u) const { return (u.e ? WB : WA) + (size_t)u.pn * 256 * 512 * 2; }
    __device__ __forceinline__ unsigned a_off(const Unit&, int row) const { return (unsigned)(row * 512) * 2u; }
};
struct EpiUp {
    static constexpr bool PERM = true;
    const bf16* GA; const bf16* GB; bf16* Y;
    __device__ __forceinline__ bool operator()(f32x4 (&acc)[2][2][4][2], const Unit& u, int wr, int wc, int fr, int fq) const {
        const int row0 = u.pm * 256 + wr * 64 + fr, col0 = u.pn * 256 + wc * 32 + 8 * fq;
        const bool fin = (u.e != 0);
#pragma unroll
        for (int ai = 0; ai < 2; ++ai)
#pragma unroll
            for (int m = 0; m < 4; ++m) {
                const size_t off = (size_t)(row0 + ai * 128 + m * 16) * 1024 + col0;
#pragma unroll
                for (int bj = 0; bj < 2; ++bj) {
                    const u32x4 gbw = *(const u32x4*)(GB + off + bj * 128);
                    float eb[8];
#pragma unroll
                    for (int j = 0; j < 4; ++j) { const float g0 = fmaxf(bf_lo(gbw[j]), -60.f), g1 = fmaxf(bf_hi(gbw[j]), -60.f); eb[2 * j] = 1.0f + ex2(-g0 * LOG2E); eb[2 * j + 1] = 1.0f + ex2(-g1 * LOG2E); }
                    if (!fin) {
                        const u32x4 gaw = *(const u32x4*)(GA + off + bj * 128);
#pragma unroll
                        for (int j = 0; j < 4; ++j) {
                            const float ea0 = 1.0f + ex2(-bf_lo(gaw[j]) * LOG2E), ea1 = 1.0f + ex2(-bf_hi(gaw[j]) * LOG2E);
                            const float r0 = eb[2 * j] * __builtin_amdgcn_rcpf(ea0), r1 = eb[2 * j + 1] * __builtin_amdgcn_rcpf(ea1);
                            if (j < 2) { acc[ai][bj][m][0][2 * j] *= r0; acc[ai][bj][m][0][2 * j + 1] *= r1; }
                            else { acc[ai][bj][m][1][2 * (j - 2)] *= r0; acc[ai][bj][m][1][2 * (j - 2) + 1] *= r1; }
                        }
                    } else {
                        float o[8];
#pragma unroll
                        for (int j = 0; j < 8; ++j) { const float a = (j < 4) ? acc[ai][bj][m][0][j] : acc[ai][bj][m][1][j - 4]; o[j] = a * __builtin_amdgcn_rcpf(eb[j]); }
                        u32x4 w; w.x = cvtpk(o[0], o[1]); w.y = cvtpk(o[2], o[3]); w.z = cvtpk(o[4], o[5]); w.w = cvtpk(o[6], o[7]);
                        *(u32x4*)(Y + off + bj * 128) = w;
                    }
                }
            }
        return fin;
    }
};

struct EpiOut {
    static constexpr bool PERM = true;
    const float* X; bf16* O;
    __device__ __forceinline__ bool operator()(const f32x4 (&acc)[2][2][4][2], const Unit& u, int wr, int wc, int fr, int fq) const {
        const int row0 = u.pm * 256 + wr * 64 + fr, col0 = u.pn * 256 + wc * 32 + 8 * fq;
#pragma unroll
        for (int ai = 0; ai < 2; ++ai)
#pragma unroll
            for (int m = 0; m < 4; ++m) {
                const size_t off = (size_t)(row0 + ai * 128 + m * 16) * 1024 + col0;
#pragma unroll
                for (int bj = 0; bj < 2; ++bj) { const f32x4 x0 = *(const f32x4*)(X + off + bj * 128), x1 = *(const f32x4*)(X + off + bj * 128 + 4);
                    const f32x4 v0 = x0 + acc[ai][bj][m][0], v1 = x1 + acc[ai][bj][m][1];
                    u32x4 w; w.x = cvtpk(v0[0], v0[1]); w.y = cvtpk(v0[2], v0[3]); w.z = cvtpk(v1[0], v1[1]); w.w = cvtpk(v1[2], v1[3]);
                    *(u32x4*)(O + off + bj * 128) = w; }
            }
        return true;
    }
};

struct MoeTables { const LAS int* tstart; const LAS int* cnt; };
template <int NPN, bool GATHER>
struct SchedMoe {
    MoeTables tb; int G, c; const char* A; const char* B; const int* ltok; int K; size_t bstride_e;
    __device__ __forceinline__ bool next(int i, Unit& u) const {
        const int T = tb.tstart[NEXP]; const long L = (long)i * G + c; if (L >= (long)T * NPN) return false;
        const int rt = (int)(L / NPN); u.pn = (int)(L % NPN); int e = 0;
#pragma unroll 1
        for (int j = 1; j < NEXP; ++j) e = (tb.tstart[j] <= rt) ? j : e;
        u.e = e; u.t = rt - tb.tstart[e]; u.cnt = tb.cnt[e]; u.slot0 = rt * 256; u.pm = rt; return true;
    }
    __device__ __forceinline__ const char* a_ptr(const Unit& u) const { return GATHER ? A : A + (size_t)u.slot0 * K * 2; }
    __device__ __forceinline__ const char* b_ptr(const Unit& u) const { return B + (size_t)u.e * bstride_e + (size_t)u.pn * 256 * K * 2; }
    __device__ __forceinline__ unsigned a_off(const Unit& u, int row) const {
        if (GATHER) { int pos = u.t * 256 + row; pos = pos < u.cnt ? pos : u.cnt - 1; const int tok = ltok[(size_t)u.e * LCAP + pos] >> 1; return (unsigned)tok * (unsigned)(K * 2); }
        return (unsigned)(row * K) * 2u;
    }
};
struct EpiMoeGU {
    static constexpr bool PERM = true;
    bf16* HID; const float* lrs;
    __device__ __forceinline__ bool operator()(const f32x4 (&acc)[2][2][4][2], const Unit& u, int wr, int wc, int fr, int fq) const {
        const int row0 = u.slot0 + wr * 64 + fr, col0 = u.pn * 128 + wc * 32 + 8 * fq;
        const float* rsp = lrs + (size_t)u.e * LCAP; const int pos0 = u.t * 256 + wr * 64 + fr;
#pragma unroll
        for (int ai = 0; ai < 2; ++ai)
#pragma unroll
            for (int m = 0; m < 4; ++m) {
                int pos = pos0 + ai * 128 + m * 16; pos = pos < u.cnt ? pos : u.cnt - 1; const float rs = rsp[pos];
                float o[8];
#pragma unroll
                for (int j = 0; j < 8; ++j) { const float g = rs * ((j < 4) ? acc[ai][0][m][0][j] : acc[ai][0][m][1][j - 4]), up = rs * ((j < 4) ? acc[ai][1][m][0][j] : acc[ai][1][m][1][j - 4]);
                    o[j] = g * sigmoidf_(g) * up; }
                u32x4 w; w.x = cvtpk(o[0], o[1]); w.y = cvtpk(o[2], o[3]); w.z = cvtpk(o[4], o[5]); w.w = cvtpk(o[6], o[7]);
                *(u32x4*)(HID + (size_t)(row0 + ai * 128 + m * 16) * 256 + col0) = w;
            }
        return true;
    }
};
struct EpiMoeDown {
    static constexpr bool PERM = true;
    bf16* YA; const int* ltok; const float* lw;
    __device__ __forceinline__ bool operator()(const f32x4 (&acc)[2][2][4][2], const Unit& u, int wr, int wc, int fr, int fq) const {
        const int col0 = u.pn * 256 + wc * 32 + 8 * fq;
        const int* lt = ltok + (size_t)u.e * LCAP; const float* lwp = lw + (size_t)u.e * LCAP;
        const int pos0 = u.t * 256 + wr * 64 + fr;
#pragma unroll
        for (int ai = 0; ai < 2; ++ai)
#pragma unroll
            for (int m = 0; m < 4; ++m) {
                const int pos = pos0 + ai * 128 + m * 16; const bool valid = pos < u.cnt; const int pc = valid ? pos : u.cnt - 1;
                int tok2 = lt[pc]; const float w8 = lwp[pc]; tok2 = valid ? tok2 : -1;
                bf16* rowp = YA + ((long)tok2 * 1024 + col0);
#pragma unroll
                for (int bj = 0; bj < 2; ++bj) { const f32x4 v0 = acc[ai][bj][m][0] * w8, v1 = acc[ai][bj][m][1] * w8;
                    u32x4 w; w.x = cvtpk(v0[0], v0[1]); w.y = cvtpk(v0[2], v0[3]); w.z = cvtpk(v1[0], v1[1]); w.w = cvtpk(v1[2], v1[3]);
                    *(u32x4*)(rowp + bj * 128) = w; }
                asm volatile("" ::: "memory");
            }
        return true;
    }
};

__device__ const double INV_FREQ[32] = {1.0, 0.7498942093324559, 0.5623413251903491, 0.4216965034285822, 0.31622776601683794, 0.23713737056616552, 0.1778279410038923, 0.1333521432163324, 0.1, 0.07498942093324558, 0.05623413251903491, 0.042169650342858224, 0.03162277660168379, 0.023713737056616554, 0.01778279410038923, 0.01333521432163324, 0.01, 0.007498942093324558, 0.005623413251903491, 0.004216965034285823, 0.0031622776601683794, 0.0023713737056616554, 0.0017782794100389228, 0.001333521432163324, 0.001, 0.0007498942093324559, 0.0005623413251903491, 0.00042169650342858224, 0.00031622776601683794, 0.00023713737056616554, 0.00017782794100389227, 0.0001333521432163324};
__device__ __forceinline__ void sincos_d(double a, float& c, float& s) {
    const double TWO_OVER_PI = 0.63661977236758134308, PIO2_HI = 1.57079632679489655800e+00, PIO2_LO = 6.12323399573676603587e-17;
    const double kd = __builtin_rint(a * TWO_OVER_PI); const int q = (int)((long long)kd & 3);
    const double r = (a - kd * PIO2_HI) - kd * PIO2_LO, r2 = r * r;
    double sp = -1.0 / 1307674368000.0; sp = sp * r2 + 1.0 / 6227020800.0; sp = sp * r2 - 1.0 / 39916800.0; sp = sp * r2 + 1.0 / 362880.0; sp = sp * r2 - 1.0 / 5040.0; sp = sp * r2 + 1.0 / 120.0; sp = sp * r2 - 1.0 / 6.0; sp = sp * r2 + 1.0;
    const double sr = sp * r;
    double cp = 1.0 / 20922789888000.0; cp = cp * r2 - 1.0 / 87178291200.0; cp = cp * r2 + 1.0 / 479001600.0; cp = cp * r2 - 1.0 / 3628800.0; cp = cp * r2 + 1.0 / 40320.0; cp = cp * r2 - 1.0 / 720.0; cp = cp * r2 + 1.0 / 24.0; cp = cp * r2 - 0.5; cp = cp * r2 + 1.0;
    const double cr = cp;
    double sv, cv;
    if (q == 0) { sv = sr; cv = cr; } else if (q == 1) { sv = cr; cv = -sr; } else if (q == 2) { sv = -sr; cv = -cr; } else { sv = -cr; cv = sr; }
    c = (float)cv; s = (float)sv;
}
__device__ __forceinline__ int map_in(int n) { if (n < 1536 || n >= 2560) return n; const int i = n & 63; return (n & ~63) + (i < 32 ? 2 * i : 2 * (i - 32) + 1); }
template <int MODE>
__device__ __forceinline__ void transpose_item(const float* W, int ldw, bf16* WT, int ldk, int k0, int n0, const float* kscale, int kmask, float kmul, LAS float* scr, int lane) {
#pragma unroll 8
    for (int i = 0; i < 32; ++i) { const int kk = 2 * i + (lane >> 5); float v = W[(size_t)(k0 + kk) * ldw + n0 + (lane & 31)]; if (kscale) v *= kscale[(k0 + kk) & kmask] * kmul; scr[kk * 33 + (lane & 31)] = v; }
    asm volatile("s_waitcnt lgkmcnt(0)" ::: "memory");
    const int c = lane & 7;
#pragma unroll
    for (int j = 0; j < 4; ++j) { const int n = (lane >> 3) + 8 * j; const LAS float* s = scr + (8 * c) * 33 + n;
        u32x4 o; o.x = cvtpk(s[0 * 33], s[1 * 33]); o.y = cvtpk(s[2 * 33], s[3 * 33]); o.z = cvtpk(s[4 * 33], s[5 * 33]); o.w = cvtpk(s[6 * 33], s[7 * 33]);
        const int nn = n0 + n; int dr;
        if (MODE == 0) dr = nn; else if (MODE == 1) dr = map_in(nn); else if (MODE == 2) dr = (nn >> 7) * 256 + (nn & 127); else dr = (nn >> 7) * 256 + 128 + (nn & 127);
        *(u32x4*)(WT + (size_t)dr * ldk + k0 + 8 * c) = o; }
    asm volatile("s_waitcnt lgkmcnt(0)" ::: "memory");
}
struct Ptrs {
    const float *x, *g_mix, *w_in, *lq1, *lk1, *lq2, *lk2, *g_sub, *w_upa, *w_upb, *w_out, *g_ffn, *w_rg, *b_rg, *w_re, *b_re, *w_eg, *w_eu, *w_ed, *g_fin;
    float* out; unsigned char* ws;
};
__device__ __forceinline__ void p0_prologue(const Ptrs& P, LAS unsigned char* lds, int vcu, int G, int wave, int lane) {
    LAS float* scr = (LAS float*)(lds + wave * 16384);
    const int gw = vcu * NWAVES + wave, NGW = G * NWAVES;
    unsigned char* ws = P.ws;
    constexpr int I_IN = 16 * 160, I_UP = 8 * 32, I_OUT = 16 * 32, I_EG = 16 * 8 * NEXP, I_ED = 4 * 32 * NEXP;
    constexpr int NITEMS = I_IN + 2 * I_UP + I_OUT + 2 * I_EG + I_ED;
    for (int it = gw; it < NITEMS; it += NGW) {
        int r = it;
        if (r < I_IN) { transpose_item<1>(P.w_in, IN_W, (bf16*)(ws + WS_WIN), 1024, (r / 160) * 64, (r % 160) * 32, nullptr, 0, 1.f, scr, lane); continue; } r -= I_IN;
        if (r < I_UP) { transpose_item<0>(P.w_upa, 1024, (bf16*)(ws + WS_WUPA), 512, (r / 32) * 64, (r % 32) * 32, nullptr, 0, 1.f, scr, lane); continue; } r -= I_UP;
        if (r < I_UP) { transpose_item<0>(P.w_upb, 1024, (bf16*)(ws + WS_WUPB), 512, (r / 32) * 64, (r % 32) * 32, P.g_sub, 127, 0.8f, scr, lane); continue; } r -= I_UP;
        if (r < I_OUT) { transpose_item<0>(P.w_out, 1024, (bf16*)(ws + WS_WOUT), 1024, (r / 32) * 64, (r % 32) * 32, nullptr, 0, 1.f, scr, lane); continue; } r -= I_OUT;
        if (r < I_EG) { const int e = r / 128, q = r % 128; transpose_item<2>(P.w_eg + (size_t)e * 1024 * 256, 256, (bf16*)(ws + WS_WGU) + (size_t)e * 512 * 1024, 1024, (q / 8) * 64, (q % 8) * 32, P.g_ffn, 1023, 1.f, scr, lane); continue; } r -= I_EG;
        if (r < I_EG) { const int e = r / 128, q = r % 128; transpose_item<3>(P.w_eu + (size_t)e * 1024 * 256, 256, (bf16*)(ws + WS_WGU) + (size_t)e * 512 * 1024, 1024, (q / 8) * 64, (q % 8) * 32, P.g_ffn, 1023, 1.f, scr, lane); continue; } r -= I_EG;
        { const int e = r / 128, q = r % 128; transpose_item<0>(P.w_ed + (size_t)e * 256 * 1024, 1024, (bf16*)(ws + WS_WDN) + (size_t)e * 1024 * 256, 256, (q / 32) * 64, (q % 32) * 32, nullptr, 0, 1.f, scr, lane); }
    }
    { const int gt = gw * 64 + lane, NGT = NGW * 64; bf16* WR = (bf16*)(ws + WS_WR);
      for (int idx = gt; idx < 48 * 1024; idx += NGT) { const int r = idx >> 10, k = idx & 1023; float v;
          if (r < 32) { const int ex = 8 * ((r & 15) >> 2) + (r & 3) + ((r >> 4) << 2); v = P.w_re[(size_t)k * 32 + ex]; } else v = P.w_rg[(size_t)k * 4 + (r & 3)];
          v *= P.g_ffn[k]; const unsigned hb = cvtpk(v, 0.f) & 0xffffu; const float hf = __uint_as_float(hb << 16); const unsigned lb = cvtpk(v - hf, 0.f) & 0xffffu;
          WR[idx] = (bf16)hb; WR[48 * 1024 + idx] = (bf16)lb; } }
    { const int gt = gw * 64 + lane, NGT = NGW * 64; f32x2* rt = (f32x2*)(ws + WS_ROPE);
      for (int idx = gt; idx < SEQ * 32; idx += NGT) { const int pos = idx >> 5, i = idx & 31; float c, s; sincos_d((double)pos * INV_FREQ[i], c, s); rt[idx] = (f32x2){c, s}; } }
    { f32x4 g[4];
#pragma unroll
      for (int j = 0; j < 4; ++j) g[j] = *((const f32x4*)P.g_mix + lane + 64 * j);
      bf16* XN = (bf16*)(ws + WS_XN);
      for (int m = gw; m < M; m += NGW) {
          const f32x4* xr = (const f32x4*)(P.x + (size_t)m * DM) + lane; f32x4 v[4]; float s = 0.f;
#pragma unroll
          for (int j = 0; j < 4; ++j) { v[j] = xr[64 * j]; s += (v[j].x * v[j].x + v[j].y * v[j].y) + (v[j].z * v[j].z + v[j].w * v[j].w); }
          const float rstd = 1.0f / sqrtf(wave_sum(s) * (1.f / DM) + EPS);
          u32x2* o8 = (u32x2*)(XN + (size_t)m * DM) + lane;
#pragma unroll
          for (int j = 0; j < 4; ++j) { const f32x4 y = v[j] * rstd * g[j]; o8[64 * j] = (u32x2){cvtpk(y.x, y.y), cvtpk(y.z, y.w)}; }
      } }
}

__device__ __forceinline__ s16x4 vtr(const LAS unsigned char* p) { return __builtin_bit_cast(s16x4, __builtin_amdgcn_ds_read_tr16_b64_v4i16((LAS v4i16_t*)p)); }
#define VFRAG(lo, hi_) ((bf16x8){lo[0], lo[1], lo[2], lo[3], hi_[0], hi_[1], hi_[2], hi_[3]})
__device__ __forceinline__ bf16x8 packp(const f32x16& p, int b) { u32x4 w; w.x = cvtpk(p[b], p[b + 1]); w.y = cvtpk(p[b + 2], p[b + 3]); w.z = cvtpk(p[b + 4], p[b + 5]); w.w = cvtpk(p[b + 6], p[b + 7]); return __builtin_bit_cast(bf16x8, w); }

constexpr int DKV_BUF = 32768, DLK = 0, DLV = 16384;
__device__ __forceinline__ void diff_unit(LAS unsigned char* lds, int b, int h, int qt, const bf16* DQ, const bf16* DK, const bf16* DV, bf16* O, float lam) {
    const int tid = threadIdx.x, lane = tid & 63, r32 = lane & 31, hi = lane >> 5; const int wid = __builtin_amdgcn_readfirstlane(tid >> 6);
    const int c = wid >> 2, wq = wid & 3;
    const size_t rowbase = (size_t)b * SEQ; const int q0 = qt * 128, NT = (q0 + 128) / 64;
    const int qmin = q0 + wq * 32, q = qmin + r32;
    const bf16* ksrc = DK + (rowbase + lane) * 512 + h * 128 + wid * 8;
    const int vp0 = 2 * wid, vp1 = 2 * wid + 1;
    const bf16* vsrc0 = DV + (rowbase + 16 * (vp0 & 3) + (lane >> 2)) * 512 + h * 128 + (vp0 >> 2) * 32 + (lane & 3) * 8;
    const bf16* vsrc1 = DV + (rowbase + 16 * (vp1 & 3) + (lane >> 2)) * 512 + h * 128 + (vp1 >> 2) * 32 + (lane & 3) * 8;
    const int kd0 = DLK + wid * 1024 + lane * 16, kd1 = DLK + (8 + wid) * 1024 + lane * 16, vd0 = DLV + vp0 * 1024 + lane * 16, vd1 = DLV + vp1 * 1024 + lane * 16;
    bf16x8 qr[4];
#pragma unroll
    for (int d0 = 0; d0 < 4; ++d0) qr[d0] = *(const bf16x8*)(DQ + (rowbase + q) * 512 + h * 128 + c * 64 + d0 * 16 + hi * 8);
    f32x16 oT[4];
#pragma unroll
    for (int i = 0; i < 4; ++i) oT[i] = (f32x16){};
    float mrun = -INFINITY, lrun = 0.f;
    u32x4 st0, st1, st2, st3;
    st0 = *(const u32x4*)ksrc; st1 = *(const u32x4*)(ksrc + 64); st2 = *(const u32x4*)vsrc0; st3 = *(const u32x4*)vsrc1;
    *(LAS u32x4*)(lds + kd0) = st0; *(LAS u32x4*)(lds + kd1) = st1; *(LAS u32x4*)(lds + vd0) = st2; *(LAS u32x4*)(lds + vd1) = st3;
    __syncthreads();
    const int kfo = (c * 8 + hi) * 1024 + r32 * 16;
    const int vfo = DLV + ((lane >> 4) & 1) * 32 + (lane & 3) * 8 + (4 * hi + ((lane & 15) >> 2)) * 64;
    for (int t = 0; t < NT; ++t) {
        const int cur = (t & 1) * DKV_BUF, nxb = DKV_BUF - cur;
        const bool pf = (t + 1 < NT);
        if (pf) { const size_t o = (size_t)(t + 1) * 64 * 512; st0 = *(const u32x4*)(ksrc + o); st1 = *(const u32x4*)(ksrc + o + 64); st2 = *(const u32x4*)(vsrc0 + o); st3 = *(const u32x4*)(vsrc1 + o); }
        if (64 * t <= qmin + 31) {
            f32x16 p0 = (f32x16){}, p1 = (f32x16){};
            const LAS unsigned char* kb = lds + cur + DLK + kfo;
#pragma unroll
            for (int d0 = 0; d0 < 4; ++d0) { const bf16x8 k0 = *(const LAS bf16x8*)(kb + d0 * 2048), k1 = *(const LAS bf16x8*)(kb + d0 * 2048 + 512);
                p0 = MFMA32(k0, qr[d0], p0); p1 = MFMA32(k1, qr[d0], p1); }
            if (64 * t + 63 > qmin) {
                const int kb0 = 64 * t + 4 * hi;
#pragma unroll
                for (int i = 0; i < 16; ++i) { const int kv = kb0 + (i & 3) + 8 * (i >> 2); if (kv > q) p0[i] = -INFINITY; if (kv + 32 > q) p1[i] = -INFINITY; }
            }
            float rm = fmaxf(p0[0], p1[0]);
#pragma unroll
            for (int i = 1; i < 16; ++i) rm = fmaxf(rm, fmaxf(p0[i], p1[i]));
            rm = fmaxf(rm, __shfl_xor(rm, 32));
            const float mn = fmaxf(mrun, rm), alpha = ex2(mrun - mn); mrun = mn;
            float ls = 0.f;
#pragma unroll
            for (int i = 0; i < 16; ++i) { p0[i] = ex2(p0[i] - mn); p1[i] = ex2(p1[i] - mn); ls += p0[i] + p1[i]; }
            lrun = lrun * alpha + ls;
#pragma unroll
            for (int d = 0; d < 4; ++d)
#pragma unroll
                for (int i = 0; i < 16; ++i) oT[d][i] *= alpha;
            const bf16x8 pf0 = packp(p0, 0), pf1 = packp(p0, 8), pf2 = packp(p1, 0), pf3 = packp(p1, 8);
            const LAS unsigned char* vb = lds + cur + vfo;
#pragma unroll
            for (int d = 0; d < 4; ++d) {
                s16x4 l0 = vtr(vb + (d * 4 + 0) * 1024), h0 = vtr(vb + (d * 4 + 0) * 1024 + 512);
                s16x4 l1 = vtr(vb + (d * 4 + 1) * 1024), h1 = vtr(vb + (d * 4 + 1) * 1024 + 512);
                s16x4 l2 = vtr(vb + (d * 4 + 2) * 1024), h2 = vtr(vb + (d * 4 + 2) * 1024 + 512);
                s16x4 l3 = vtr(vb + (d * 4 + 3) * 1024), h3 = vtr(vb + (d * 4 + 3) * 1024 + 512);
                oT[d] = MFMA32(VFRAG(l0, h0), pf0, oT[d]); oT[d] = MFMA32(VFRAG(l1, h1), pf1, oT[d]);
                oT[d] = MFMA32(VFRAG(l2, h2), pf2, oT[d]); oT[d] = MFMA32(VFRAG(l3, h3), pf3, oT[d]);
            }
        }
        if (pf) { *(LAS u32x4*)(lds + nxb + kd0) = st0; *(LAS u32x4*)(lds + nxb + kd1) = st1; *(LAS u32x4*)(lds + nxb + vd0) = st2; *(LAS u32x4*)(lds + nxb + vd1) = st3; }
        __syncthreads();
    }
    const float lt = lrun + __shfl_xor(lrun, 32); const float inv = 1.0f / lt;
    LAS f32x4* xch = (LAS f32x4*)lds + (size_t)wq * 1024 + lane;
    if (c == 1) {
        const float sc = inv * lam;
#pragma unroll
        for (int d = 0; d < 4; ++d)
#pragma unroll
            for (int g = 0; g < 4; ++g) xch[(d * 4 + g) * 64] = (f32x4){oT[d][4 * g] * sc, oT[d][4 * g + 1] * sc, oT[d][4 * g + 2] * sc, oT[d][4 * g + 3] * sc};
    }
    __syncthreads();
    if (c == 0) {
        float ss = 0.f;
#pragma unroll
        for (int d = 0; d < 4; ++d)
#pragma unroll
            for (int g = 0; g < 4; ++g) { const f32x4 o2 = xch[(d * 4 + g) * 64];
#pragma unroll
                for (int j = 0; j < 4; ++j) { const float v = oT[d][4 * g + j] * inv - o2[j]; oT[d][4 * g + j] = v; ss += v * v; } }
        ss += __shfl_xor(ss, 32);
        const float rstd = 1.0f / sqrtf(ss * (1.0f / 128.0f) + EPS);
        bf16* orow = O + (rowbase + q) * 512 + h * 128 + 4 * hi;
#pragma unroll
        for (int d = 0; d < 4; ++d)
#pragma unroll
            for (int g = 0; g < 4; ++g) *(u32x2*)(orow + d * 32 + g * 8) = (u32x2){cvtpk(oT[d][4 * g] * rstd, oT[d][4 * g + 1] * rstd), cvtpk(oT[d][4 * g + 2] * rstd, oT[d][4 * g + 3] * rstd)};
    }
    __syncthreads();
}

__device__ __forceinline__ void sb_block(f32x16& z, int kbase, int q, int hi, float& carry) {
    float s[16], T[4], To[4], P[4];
    bool vis[16];
#pragma unroll
    for (int i = 0; i < 16; ++i) { const int key = kbase + (i & 3) + 8 * (i >> 2); vis[i] = key < q; const float e = ex2(fminf(z[i], 126.f)); const float l = lg2(1.0f + e); s[i] = vis[i] ? l : 0.f; }
#pragma unroll
    for (int g = 0; g < 4; ++g) { s[4 * g + 2] += s[4 * g + 3]; s[4 * g + 1] += s[4 * g + 2]; s[4 * g] += s[4 * g + 1]; T[g] = s[4 * g]; }
#pragma unroll
    for (int g = 0; g < 4; ++g) { To[g] = __shfl_xor(T[g], 32); P[g] = T[g] + To[g]; }
    const float sp2 = P[3], sp1 = P[3] + P[2], sp0 = sp1 + P[1], tot = sp0 + P[0];
    const float suf[4] = {sp0, sp1, sp2, 0.f};
#pragma unroll
    for (int g = 0; g < 4; ++g) { const float off = carry + suf[g] + (hi == 0 ? To[g] : 0.f);
#pragma unroll
        for (int j = 0; j < 4; ++j) { const float a = ex2(z[4 * g + j] - (off + s[4 * g + j])); z[4 * g + j] = vis[4 * g + j] ? a : 0.f; } }
    carry += tot;
}
constexpr int SKV_BUF = 16384, SLK = 0, SLV = 8192, SFLAG = 32768;
__device__ __forceinline__ void sb_unit(LAS unsigned char* lds, int b, int h, int qt, const bf16* Q, const bf16* Kg, const bf16* Vg, bf16* O) {
    const int tid = threadIdx.x, lane = tid & 63, r32 = lane & 31, hi = lane >> 5; const int wid = __builtin_amdgcn_readfirstlane(tid >> 6);
    const size_t rowbase = (size_t)b * SEQ; const int q0 = qt * 256, qmin = q0 + wid * 32, q = qmin + r32;
    const int ttop = (q0 + 255) >> 6, ttw = (qmin + 31) >> 6;
    const bf16* ksrc = Kg + (rowbase + lane) * 512 + h * 64 + wid * 8;
    const bf16* vsrc = Vg + (rowbase + 16 * (wid & 3) + (lane >> 2)) * 512 + h * 64 + (wid >> 2) * 32 + (lane & 3) * 8;
    const int kd = SLK + wid * 1024 + lane * 16, vd = SLV + wid * 1024 + lane * 16;
    bf16x8 qr[4];
#pragma unroll
    for (int d0 = 0; d0 < 4; ++d0) qr[d0] = *(const bf16x8*)(Q + (rowbase + q) * 512 + h * 64 + d0 * 16 + hi * 8);
    f32x16 oT[2]; oT[0] = (f32x16){}; oT[1] = (f32x16){};
    float carry = 0.f; bool fin = false;
    volatile LAS unsigned* flags = (volatile LAS unsigned*)(lds + SFLAG);
    u32x4 st0, st1;
    { const size_t o = (size_t)ttop * 64 * 512; st0 = *(const u32x4*)(ksrc + o); st1 = *(const u32x4*)(vsrc + o); }
    *(LAS u32x4*)(lds + kd) = st0; *(LAS u32x4*)(lds + vd) = st1;
    __syncthreads();
    const int kfo = hi * 1024 + r32 * 16;
    const int vfo = SLV + ((lane >> 4) & 1) * 32 + (lane & 3) * 8 + (4 * hi + ((lane & 15) >> 2)) * 64;
    int par = 0;
    for (int t = ttop; t >= 0; --t) {
        const int cur = par * SKV_BUF, nxb = SKV_BUF - cur;
        const bool pf = (t > 0);
        if (pf) { const size_t o = (size_t)(t - 1) * 64 * 512; st0 = *(const u32x4*)(ksrc + o); st1 = *(const u32x4*)(vsrc + o); }
        if (t <= ttw && !fin) {
            f32x16 p0 = (f32x16){}, p1 = (f32x16){};
            const LAS unsigned char* kb = lds + cur + SLK + kfo;
#pragma unroll
            for (int d0 = 0; d0 < 4; ++d0) { const bf16x8 k0 = *(const LAS bf16x8*)(kb + d0 * 2048), k1 = *(const LAS bf16x8*)(kb + d0 * 2048 + 512);
                p0 = MFMA32(k0, qr[d0], p0); p1 = MFMA32(k1, qr[d0], p1); }
            sb_block(p1, 64 * t + 32 + 4 * hi, q, hi, carry);
            sb_block(p0, 64 * t + 4 * hi, q, hi, carry);
            const bf16x8 pf0 = packp(p0, 0), pf1 = packp(p0, 8), pf2 = packp(p1, 0), pf3 = packp(p1, 8);
            const LAS unsigned char* vb = lds + cur + vfo;
#pragma unroll
            for (int d = 0; d < 2; ++d) {
                s16x4 l0 = vtr(vb + (d * 4 + 0) * 1024), h0 = vtr(vb + (d * 4 + 0) * 1024 + 512);
                s16x4 l1 = vtr(vb + (d * 4 + 1) * 1024), h1 = vtr(vb + (d * 4 + 1) * 1024 + 512);
                s16x4 l2 = vtr(vb + (d * 4 + 2) * 1024), h2 = vtr(vb + (d * 4 + 2) * 1024 + 512);
                s16x4 l3 = vtr(vb + (d * 4 + 3) * 1024), h3 = vtr(vb + (d * 4 + 3) * 1024 + 512);
                oT[d] = MFMA32(VFRAG(l0, h0), pf0, oT[d]); oT[d] = MFMA32(VFRAG(l1, h1), pf1, oT[d]);
                oT[d] = MFMA32(VFRAG(l2, h2), pf2, oT[d]); oT[d] = MFMA32(VFRAG(l3, h3), pf3, oT[d]);
            }
            fin = __all(carry > SB_STOP);
        }
        if (pf) { *(LAS u32x4*)(lds + nxb + kd) = st0; *(LAS u32x4*)(lds + nxb + vd) = st1; }
        if (lane == 0) flags[par * 8 + wid] = fin ? 1u : 0u;
        __syncthreads();
        unsigned all = 1u;
#pragma unroll
        for (int w = 0; w < 8; ++w) all &= flags[par * 8 + w];
        par ^= 1;
        if (all) break;
    }
    bf16* orow = O + (rowbase + q) * 512 + h * 64 + 4 * hi;
#pragma unroll
    for (int d = 0; d < 2; ++d)
#pragma unroll
        for (int g = 0; g < 4; ++g) *(u32x2*)(orow + d * 32 + g * 8) = (u32x2){cvtpk(oT[d][4 * g], oT[d][4 * g + 1]), cvtpk(oT[d][4 * g + 2], oT[d][4 * g + 3])};
    __syncthreads();
}

constexpr int R_ROWB = 1040, R_REC = 102400;
__device__ __forceinline__ void p5_router(const Ptrs& P, LAS unsigned char* lds, int vcu, int G, int wave, int lane) {
    const int tid = threadIdx.x, t = lane & 15, kq = lane >> 4;
    LAS int* rec_e = (LAS int*)(lds + R_REC); LAS float* rec_w = (LAS float*)(lds + R_REC + 1024); LAS int* rec_p = (LAS int*)(lds + R_REC + 2048);
    LAS float* rec_rs = (LAS float*)(lds + R_REC + 3072); LAS int* lcnt = (LAS int*)(lds + R_REC + 3584); LAS int* lbase = (LAS int*)(lds + R_REC + 3584 + 128);
    const bf16* X1B = (const bf16*)(P.ws + WS_X1B); const bf16* WR = (const bf16*)(P.ws + WS_WR);
    int* gcnt = (int*)(P.ws + WS_CTL) + CW_CNT; int* ltok = (int*)(P.ws + WS_LTOK); float* lw = (float*)(P.ws + WS_LW); float* lrs = (float*)(P.ws + WS_LRS);
    if (tid < 32) lcnt[tid] = 0;
    float bg[4], be[8];
#pragma unroll
    for (int r = 0; r < 4; ++r) { bg[r] = P.b_rg[r]; be[r] = P.b_re[8 * kq + r]; be[4 + r] = P.b_re[8 * kq + 4 + r]; }
    for (int ch = vcu; ch < M / 128; ch += G) {
        const int lrow = wave * 16 + t, row = ch * 128 + lrow;
        const bf16* xrow = X1B + (size_t)row * DM + kq * 8;
        f32x4 acc0 = (f32x4){0.f, 0.f, 0.f, 0.f}, acc1 = acc0, acc2 = acc0; float ss = 0.f;
#pragma unroll 1
        for (int half = 0; half < 2; ++half) {
            __syncthreads();
            for (int idx = tid; idx < 96 * 64; idx += NTHREADS) { const int rr = idx >> 6, c16 = idx & 63; *(LAS u32x4*)(lds + rr * R_ROWB + c16 * 16) = *(const u32x4*)(WR + (size_t)rr * 1024 + half * 512 + c16 * 8); }
            bf16x8 a[16];
#pragma unroll
            for (int ks = 0; ks < 16; ++ks) a[ks] = *(const bf16x8*)(xrow + half * 512 + ks * 32);
            __syncthreads();
#pragma unroll
            for (int ks = 0; ks < 16; ++ks) {
                const u32x4 aw = __builtin_bit_cast(u32x4, a[ks]);
#pragma unroll
                for (int j = 0; j < 4; ++j) { const float f0 = bf_lo(aw[j]), f1 = bf_hi(aw[j]); ss += f0 * f0 + f1 * f1; }
                const LAS unsigned char* wp = lds + t * R_ROWB + ks * 64 + kq * 16;
                acc0 = __builtin_amdgcn_mfma_f32_16x16x32_bf16(*(const LAS bf16x8*)(wp), a[ks], acc0, 0, 0, 0);
                acc0 = __builtin_amdgcn_mfma_f32_16x16x32_bf16(*(const LAS bf16x8*)(wp + 48 * R_ROWB), a[ks], acc0, 0, 0, 0);
                acc1 = __builtin_amdgcn_mfma_f32_16x16x32_bf16(*(const LAS bf16x8*)(wp + 16 * R_ROWB), a[ks], acc1, 0, 0, 0);
                acc1 = __builtin_amdgcn_mfma_f32_16x16x32_bf16(*(const LAS bf16x8*)(wp + 64 * R_ROWB), a[ks], acc1, 0, 0, 0);
                acc2 = __builtin_amdgcn_mfma_f32_16x16x32_bf16(*(const LAS bf16x8*)(wp + 32 * R_ROWB), a[ks], acc2, 0, 0, 0);
                acc2 = __builtin_amdgcn_mfma_f32_16x16x32_bf16(*(const LAS bf16x8*)(wp + 80 * R_ROWB), a[ks], acc2, 0, 0, 0);
            }
        }
        ss += __shfl_xor(ss, 16); ss += __shfl_xor(ss, 32);
        const float rstd = 1.0f / sqrtf(ss * (1.f / DM) + EPS);
        float gl[4], el[8];
#pragma unroll
        for (int r = 0; r < 4; ++r) { gl[r] = acc2[r] * rstd + bg[r]; el[r] = acc0[r] * rstd + be[r]; el[4 + r] = acc1[r] * rstd + be[4 + r]; }
        int gi = 0; float gm = gl[0];
#pragma unroll
        for (int e = 1; e < 4; ++e) if (gl[e] > gm) { gm = gl[e]; gi = e; }
        float gs = 0.f;
#pragma unroll
        for (int e = 0; e < 4; ++e) gs += __expf(gl[e] - gm);
        const float pg = 1.0f / gs;
        int i1 = 0; float m1 = el[0];
#pragma unroll
        for (int j = 1; j < 8; ++j) if (el[j] > m1) { m1 = el[j]; i1 = j; }
        int i2 = -1; float m2 = -INFINITY;
#pragma unroll
        for (int j = 0; j < 8; ++j) if (j != i1 && el[j] > m2) { m2 = el[j]; i2 = j; }
        const float r = __expf(m2 - m1), w1 = pg / (1.0f + r), w2 = pg * r / (1.0f + r);
        if (kq == gi) {
            const int e1 = gi * 8 + i1, e2 = gi * 8 + i2;
            rec_e[lrow * 2] = e1; rec_e[lrow * 2 + 1] = e2; rec_w[lrow * 2] = w1; rec_w[lrow * 2 + 1] = w2; rec_rs[lrow] = rstd;
            rec_p[lrow * 2] = __hip_atomic_fetch_add(&lcnt[e1], 1, __ATOMIC_RELAXED, __HIP_MEMORY_SCOPE_WORKGROUP); rec_p[lrow * 2 + 1] = __hip_atomic_fetch_add(&lcnt[e2], 1, __ATOMIC_RELAXED, __HIP_MEMORY_SCOPE_WORKGROUP);
        }
        __syncthreads();
        if (tid < 32) { const int n = lcnt[tid]; lbase[tid] = n ? atomicAdd(gcnt + 64 * tid, n) : 0; }
        __syncthreads();
        if (tid < 256) { const int e = rec_e[tid]; const size_t idx = (size_t)e * LCAP + lbase[e] + rec_p[tid]; ltok[idx] = (ch * 128 + (tid >> 1)) * 2 + (tid & 1); lw[idx] = rec_w[tid]; lrs[idx] = rec_rs[tid >> 1]; }
        if (tid < 32) lcnt[tid] = 0;
    }
    __syncthreads();
}
__device__ __forceinline__ MoeTables moe_tables(const Ptrs& P, LAS unsigned char* lds) {
    LAS int* tstart = (LAS int*)(lds + SCHED_OFF); LAS int* cnt = (LAS int*)(lds + SCHED_OFF + 256);
    const int tid = threadIdx.x;
    if (tid < 32) cnt[tid] = (int)__hip_atomic_load((unsigned*)(P.ws + WS_CTL) + CW_CNT + 64 * tid, RLX_AGENT);
    __syncthreads();
    if (tid == 0) { int a = 0; for (int e = 0; e < NEXP; ++e) { tstart[e] = a; a += (cnt[e] + 255) >> 8; } tstart[NEXP] = a; }
    __syncthreads();
    MoeTables tb; tb.tstart = tstart; tb.cnt = cnt; return tb;
}
__device__ __forceinline__ void p8_final(const Ptrs& P, int vcu, int G, int wave, int lane) {
    const int gw = vcu * NWAVES + wave, NGW = G * NWAVES;
    f32x4 g[4];
#pragma unroll
    for (int j = 0; j < 4; ++j) g[j] = *((const f32x4*)P.g_fin + lane + 64 * j);
    const bf16* YA = (const bf16*)(P.ws + WS_YA); const bf16* X1B = (const bf16*)(P.ws + WS_X1B);
    for (int m = gw; m < M; m += NGW) {
        f32x4* xr = (f32x4*)(P.out + (size_t)m * DM) + lane; const u32x2* xb = (const u32x2*)(X1B + (size_t)m * DM) + lane;
        const u32x2* y0 = (const u32x2*)(YA + (size_t)(2 * m) * DM) + lane; const u32x2* y1 = (const u32x2*)(YA + (size_t)(2 * m + 1) * DM) + lane;
        f32x4 v[4]; float s = 0.f;
#pragma unroll
        for (int j = 0; j < 4; ++j) { const u32x2 xv = xb[64 * j], a = y0[64 * j], b2 = y1[64 * j];
            v[j].x = bf_lo(xv.x) + bf_lo(a.x) + bf_lo(b2.x); v[j].y = bf_hi(xv.x) + bf_hi(a.x) + bf_hi(b2.x); v[j].z = bf_lo(xv.y) + bf_lo(a.y) + bf_lo(b2.y); v[j].w = bf_hi(xv.y) + bf_hi(a.y) + bf_hi(b2.y);
            s += (v[j].x * v[j].x + v[j].y * v[j].y) + (v[j].z * v[j].z + v[j].w * v[j].w); }
        const float rstd = 1.0f / sqrtf(wave_sum(s) * (1.f / DM) + EPS);
#pragma unroll
        for (int j = 0; j < 4; ++j) xr[64 * j] = v[j] * rstd * g[j];
    }
}

struct Args { Ptrs p; int ph_lo, ph_hi; };
__global__ void __launch_bounds__(NTHREADS, 2) fwd_kernel(Args args) {
    extern __shared__ __attribute__((aligned(16))) unsigned char lds_raw[];
    LAS unsigned char* lds = (LAS unsigned char*)lds_raw;
    const Ptrs& P = args.p;
    const int tid = threadIdx.x, lane = tid & 63, wave = __builtin_amdgcn_readfirstlane(tid >> 6);
    const int G = gridDim.x, bx = blockIdx.x; const int vcu = (G % 8 == 0) ? (bx % 8) * (G / 8) + bx / 8 : bx;
    unsigned char* ws = P.ws;
    volatile LAS unsigned* MISC = (volatile LAS unsigned*)(lds + MISC_OFF);
    if (tid < 64) MISC[tid] = 0u;
    __syncthreads();
    XcdBarrier bar = xcd_barrier_post((unsigned*)(ws + WS_CTL) + CW_BAR, MISC);
    const int lo = args.ph_lo, hi_ = args.ph_hi;
#ifndef PH_MASK
#define PH_MASK 0x1ff
#endif
#define IN(k) (((PH_MASK >> (k)) & 1) && lo <= (k) && (k) < hi_)
#define SEAM(k) do { if (IN(k) && IN((k) + 1)) xcd_barrier(bar); } while (0)

#ifndef DUP
#define DUP -1
#endif
#define BODY0 { p0_prologue(P, lds, vcu, G, wave, lane); }
#define BODY1 { SchedDense S; S.T.init(M, IN_W, G, bx); S.A = (const char*)(ws + WS_XN); S.B = (const char*)(ws + WS_WIN); S.K = 1024; \
        EpiInProj E{ws, (const f32x4*)(ws + WS_ROPE)}; \
        pg8::gemm_phase<EpiInProj, SchedDense, true>(lds, 1024, S, E); }
#define BODY2D(OPTR) { \
        for (int i = 0; ; ++i) { int bh, qt; \
            if (G == 256) { if (i >= 4) break; const int s = vcu & 7; bh = vcu >> 3; qt = (i == 0) ? s : (i == 1) ? 15 - s : (i == 2) ? 16 + s : 31 - s; } \
            else { const int u = i * G + vcu; if (u >= 1024) break; bh = u >> 5; qt = u & 31; } \
            diff_unit(lds, bh >> 2, bh & 3, qt, DQ, DK, DV, (bf16*)(OPTR), lam); } }
#define BODY2S(OPTR) { \
        for (int i = 0; ; ++i) { int bh, qt; \
            if (G == 256) { if (i >= 4) break; const int s = vcu & 3; bh = vcu >> 2; qt = (i == 0) ? s : (i == 1) ? 7 - s : (i == 2) ? 8 + s : 15 - s; } \
            else { const int u = i * G + vcu; if (u >= 1024) break; bh = u >> 4; qt = u & 15; } \
            sb_unit(lds, bh >> 3, bh & 7, qt, SQ, SK, SV, (bf16*)(OPTR)); } }
#define BODY3 { SchedUp S; S.T.init(M, 1024, G, bx); S.OA = (const char*)(ws + WS_SBQ); S.OB = (const char*)(ws + WS_SBQ + 3 * WS_SMALL_STRIDE); S.WA = (const char*)(ws + WS_WUPA); S.WB = (const char*)(ws + WS_WUPB); \
        EpiUp E{(const bf16*)(ws + WS_GA), (const bf16*)(ws + WS_GB), (bf16*)(ws + WS_XN)}; \
        pg8::gemm_phase<EpiUp, SchedUp, true>(lds, 512, S, E); }
#define BODY4 { SchedDense S; S.T.init(M, 1024, G, bx); S.A = (const char*)(ws + WS_XN); S.B = (const char*)(ws + WS_WOUT); S.K = 1024; \
        EpiOut E{P.x, (bf16*)(ws + WS_X1B)}; \
        pg8::gemm_phase<EpiOut, SchedDense, true>(lds, 1024, S, E); }
#define BODY6 { const MoeTables tb = moe_tables(P, lds); \
        SchedMoe<2, true> S{tb, G, bx, (const char*)(ws + WS_X1B), (const char*)(ws + WS_WGU), (const int*)(ws + WS_LTOK), 1024, (size_t)512 * 1024 * 2}; \
        EpiMoeGU E{(bf16*)(ws + WS_HID), (const float*)(ws + WS_LRS)}; \
        pg8::gemm_phase<EpiMoeGU, SchedMoe<2, true>, true>(lds, 1024, S, E); }
#define BODY7 { const MoeTables tb = moe_tables(P, lds); \
        SchedMoe<4, false> S{tb, G, bx, (const char*)(ws + WS_HID), (const char*)(ws + WS_WDN), (const int*)(ws + WS_LTOK), 256, (size_t)1024 * 256 * 2}; \
        EpiMoeDown E{(bf16*)(ws + WS_YA), (const int*)(ws + WS_LTOK), (const float*)(ws + WS_LW)}; \
        pg8::gemm_phase<EpiMoeDown, SchedMoe<4, false>, true>(lds, 256, S, E); }

    if (IN(0)) { BODY0 if (DUP == 0) { xcd_barrier(bar); BODY0 } }
    SEAM(0);
    if (IN(1)) { BODY1 if (DUP == 1) { xcd_barrier(bar); BODY1 } }
    SEAM(1);
    if (IN(2)) {
        LAS float* lamp = (LAS float*)(lds + 65536 + 4096);
        if (wave == 0) { const float a = wave_sum(P.lq1[lane] * P.lk1[lane]), b2 = wave_sum(P.lq2[lane] * P.lk2[lane]); if (lane == 0) lamp[0] = __expf(a) - __expf(b2) + 0.2f; }
        __syncthreads();
        const float lam = lamp[0];
        const bf16* DQ = (const bf16*)(ws + WS_SBQ + 3 * WS_SMALL_STRIDE); const bf16* DK = (const bf16*)(ws + WS_SBQ + 4 * WS_SMALL_STRIDE); const bf16* DV = (const bf16*)(ws + WS_SBQ + 5 * WS_SMALL_STRIDE);
        const bf16* SQ = (const bf16*)(ws + WS_SBQ); const bf16* SK = (const bf16*)(ws + WS_SBQ + 1 * WS_SMALL_STRIDE); const bf16* SV = (const bf16*)(ws + WS_SBQ + 2 * WS_SMALL_STRIDE);
        if (DUP == 20) { BODY2D(ws + WS_XN) }
        BODY2D(DQ)
        if (DUP == 21) { BODY2S(ws + WS_XN) }
        BODY2S(SQ)
    }
    SEAM(2);
    if (IN(3)) { BODY3 if (DUP == 3) { xcd_barrier(bar); BODY3 } }
    SEAM(3);
    if (IN(4)) { BODY4 if (DUP == 4) { xcd_barrier(bar); BODY4 } }
    SEAM(4);
    if (IN(5)) { p5_router(P, lds, vcu, G, wave, lane);
        if (DUP == 5) { xcd_barrier(bar); if (bx == 0 && tid < 32) __hip_atomic_store((unsigned*)(ws + WS_CTL) + CW_CNT + 64 * tid, 0u, RLX_AGENT); xcd_barrier(bar); p5_router(P, lds, vcu, G, wave, lane); } }
    SEAM(5);
    if (IN(6)) { BODY6 if (DUP == 6) { xcd_barrier(bar); BODY6 } }
    SEAM(6);
    if (IN(7)) { BODY7 if (DUP == 7) { xcd_barrier(bar); BODY7 } }
    SEAM(7);
    if (IN(8)) { p8_final(P, vcu, G, wave, lane); }
#undef IN
#undef SEAM
}

#ifndef MK_N_LAUNCHES
#define MK_N_LAUNCHES 1
#endif
extern "C" void kernel_launch(void* const* d_in, const int* in_sizes, int n_in, void* d_out, int out_size, void* d_ws, size_t ws_size, hipStream_t stream) {
    static int grid = 0;
    if (grid == 0) {
        if (n_in != 20 || in_sizes[0] != M * DM || out_size != M * DM || ws_size < WS_END) { fprintf(stderr, "kernel_launch: unexpected shapes (n_in %d, in0 %d, out %d, ws %zu)\n", n_in, n_in > 0 ? in_sizes[0] : -1, out_size, ws_size); grid = -1; return; }
        int dev = 0, cus = 0, per_cu = 0;
        if (hipGetDevice(&dev) != hipSuccess || hipDeviceGetAttribute(&cus, hipDeviceAttributeMultiprocessorCount, dev) != hipSuccess) { grid = -1; return; }
        if (hipFuncSetAttribute((const void*)fwd_kernel, hipFuncAttributeMaxDynamicSharedMemorySize, LDS_BYTES) != hipSuccess) { fprintf(stderr, "kernel_launch: hipFuncSetAttribute failed\n"); grid = -1; return; }
        if (hipOccupancyMaxActiveBlocksPerMultiprocessor(&per_cu, (const void*)fwd_kernel, NTHREADS, LDS_BYTES) != hipSuccess || per_cu < 1) fprintf(stderr, "kernel_launch: occupancy query reports %d\n", per_cu);
        (void)hipGetLastError();
        grid = cus;
    }
    if (grid < 0) return;
    (void)hipMemsetAsync((char*)d_ws + WS_CTL, 0, CTL_ZERO_BYTES, stream);
    Args a{};
    const float** pp = (const float**)&a.p;
    for (int i = 0; i < 20; ++i) pp[i] = (const float*)d_in[i];
    a.p.out = (float*)d_out; a.p.ws = (unsigned char*)d_ws;
#if MK_N_LAUNCHES == 1
    a.ph_lo = 0; a.ph_hi = 9;
    hipLaunchKernelGGL(fwd_kernel, dim3(grid), dim3(NTHREADS), LDS_BYTES, stream, a);
#else
    for (int ph = 0; ph < 9; ++ph) { a.ph_lo = ph; a.ph_hi = ph + 1; hipLaunchKernelGGL(fwd_kernel, dim3(grid), dim3(NTHREADS), LDS_BYTES, stream, a); }
#endif
}
```
